# Optimizing an MI355X kernel written in HIP

```python
import jax, jax.numpy as jnp
from jax import lax
import numpy as np

D_MODEL = 1024
BATCH = 4
SEQ = 4096
DEPTH = 1

CHUNK = 64
MIX_WIDTH = D_MODEL
HGRN_WIDTH = MIX_WIDTH // 2
CONV_WIDTH = MIX_WIDTH - HGRN_WIDTH
HGRN_HEAD_DIM = 128
HGRN_HEADS = HGRN_WIDTH // HGRN_HEAD_DIM
CONV_K = 3
D_FF = 4 * D_MODEL
ALPHA = (2 * DEPTH) ** 0.25
BETA = (8 * DEPTH) ** -0.25
EPS = 1e-5
IN_COLS = 4 * HGRN_WIDTH + 3 * CONV_WIDTH
SPLITS = (HGRN_WIDTH, 2 * HGRN_WIDTH, 3 * HGRN_WIDTH, 4 * HGRN_WIDTH,
          4 * HGRN_WIDTH + CONV_WIDTH, 4 * HGRN_WIDTH + 2 * CONV_WIDTH)

kernel_name = "hybrid_hgrn2_shortconv_deepnorm_layer"


def layer_norm(x, g, b):
    xf = x.astype(jnp.float32)
    mu = jnp.mean(xf, axis=-1, keepdims=True)
    xc = xf - mu
    var = jnp.mean(jnp.square(xc), axis=-1, keepdims=True)
    y = xc * lax.rsqrt(var + EPS) * g.astype(jnp.float32) + b.astype(jnp.float32)
    return y.astype(x.dtype)


def hgrn2_chunkwise(q, k, v, g):
    bsz, seq, n_h, d_k = q.shape
    d_v = v.shape[-1]
    n_c = seq // CHUNK

    def to_chunks(a):
        return a.reshape(bsz, n_c, CHUNK, n_h, a.shape[-1]).transpose(1, 0, 3, 2, 4)

    q, k, v, g = to_chunks(q), to_chunks(k), to_chunks(v), to_chunks(g)
    b = jnp.cumsum(g, axis=-2)
    b_ref = b[..., CHUNK // 2:CHUNK // 2 + 1, :]
    b_last = b[..., -1:, :]
    causal = jnp.tril(jnp.ones((CHUNK, CHUNK), dtype=bool))
    scores = jnp.einsum('nbhck,nbhsk->nbhcs', q * jnp.exp(b - b_ref), k * jnp.exp(b_ref - b))
    scores = jnp.where(causal, scores, 0.0)
    o_intra = jnp.einsum('nbhcs,nbhsv->nbhcv', scores, v)
    q_inter = q * jnp.exp(b)
    k_state = k * jnp.exp(b_last - b)
    chunk_decay = jnp.exp(b_last[..., 0, :])

    def step(state, inp):
        q_c, k_c, v_c, d_c = inp
        o_c = jnp.einsum('bhck,bhkv->bhcv', q_c, state)
        state = d_c[..., None] * state + jnp.einsum('bhck,bhcv->bhkv', k_c, v_c)
        return state, o_c

    s0 = jnp.zeros((bsz, n_h, d_k, d_v), q.dtype)
    _, o_inter = lax.scan(step, s0, (q_inter, k_state, v, chunk_decay))
    o = o_intra + o_inter
    return o.transpose(1, 0, 3, 2, 4).reshape(bsz, seq, n_h, d_v)


def causal_depthwise_conv(z, w):
    rhs = w.astype(z.dtype).reshape(CONV_K, 1, z.shape[-1])
    return lax.conv_general_dilated(
        z, rhs, window_strides=(1,), padding=[(CONV_K - 1, 0)],
        dimension_numbers=('NWC', 'WIO', 'NWC'), feature_group_count=z.shape[-1])


def token_mixer(h, w_in, lower_bound, gate_norm_w, conv_w, w_out):
    bsz, seq, _ = h.shape
    proj = h @ w_in
    q, f_pre, i_in, o_gate, b_gate, c_gate, u = jnp.split(proj, SPLITS, axis=-1)

    f = lower_bound + (1.0 - lower_bound) * jax.nn.sigmoid(f_pre.astype(jnp.float32))
    log_f = jnp.log(f)
    k = 1.0 - f
    heads = lambda a: a.reshape(bsz, seq, HGRN_HEADS, HGRN_HEAD_DIM)
    o = hgrn2_chunkwise(heads(q.astype(jnp.float32)), heads(k),
                        heads(i_in.astype(jnp.float32)), heads(log_f))
    o = o * lax.rsqrt(jnp.mean(jnp.square(o), axis=-1, keepdims=True) + EPS)
    o = o.reshape(bsz, seq, HGRN_WIDTH) * gate_norm_w.astype(jnp.float32) \
        * jax.nn.silu(o_gate.astype(jnp.float32))
    o = o.astype(h.dtype)

    y = b_gate * causal_depthwise_conv(c_gate * u, conv_w)

    return jnp.concatenate([o, y], axis=-1) @ w_out


def squared_relu_mlp(h, w1, w2):
    return jnp.square(jax.nn.relu(h @ w1)) @ w2


def setup_inputs(seed: int = 0) -> dict:
    key = jax.random.key(seed)
    ks = jax.random.split(key, 12)
    nrm = lambda k, shape: jax.random.normal(k, shape, jnp.float32)
    return {
        "x": nrm(ks[0], (BATCH, SEQ, D_MODEL)),
        "w_in": nrm(ks[1], (DEPTH, D_MODEL, IN_COLS)) * D_MODEL ** -0.5,
        "lb_logits": 0.1 * nrm(ks[2], (DEPTH + 1, HGRN_WIDTH)),
        "gate_norm_w": 1.0 + 0.02 * nrm(ks[3], (DEPTH, HGRN_WIDTH)),
        "conv_w": nrm(ks[4], (DEPTH, CONV_K, CONV_WIDTH)) * CONV_K ** -0.5,
        "w_out": nrm(ks[5], (DEPTH, MIX_WIDTH, D_MODEL)) * (MIX_WIDTH ** -0.5 * BETA),
        "ln1_g": 1.0 + 0.02 * nrm(ks[6], (DEPTH, D_MODEL)),
        "ln1_b": 0.02 * nrm(ks[7], (DEPTH, D_MODEL)),
        "w_ff1": nrm(ks[8], (DEPTH, D_MODEL, D_FF)) * D_MODEL ** -0.5,
        "w_ff2": nrm(ks[9], (DEPTH, D_FF, D_MODEL)) * (D_FF ** -0.5 * BETA),
        "ln2_g": 1.0 + 0.02 * nrm(ks[10], (DEPTH, D_MODEL)),
        "ln2_b": 0.02 * nrm(ks[11], (DEPTH, D_MODEL)),
    }


def reference(x, w_in, lb_logits, gate_norm_w, conv_w, w_out, ln1_g, ln1_b,
              w_ff1, w_ff2, ln2_g, ln2_b):
    lower_bounds = jnp.cumsum(jax.nn.softmax(lb_logits.astype(jnp.float32), axis=0), axis=0)
    h = x
    for l in range(DEPTH):
        mix = token_mixer(h, w_in[l], lower_bounds[l], gate_norm_w[l], conv_w[l], w_out[l])
        h = layer_norm(ALPHA * h + mix, ln1_g[l], ln1_b[l])
        h = layer_norm(ALPHA * h + squared_relu_mlp(h, w_ff1[l], w_ff2[l]), ln2_g[l], ln2_b[l])
    return h
```

```cpp
#include <hip/hip_runtime.h>
#include <hip/hip_cooperative_groups.h>
#include <cstdio>
namespace cg = cooperative_groups;

#define LAS __attribute__((address_space(3)))
typedef unsigned short bf16_t;
typedef short bf16x8 __attribute__((ext_vector_type(8)));
typedef float f32x4 __attribute__((ext_vector_type(4)));
typedef float f32x2 __attribute__((ext_vector_type(2)));
typedef unsigned u32x4 __attribute__((ext_vector_type(4)));
typedef unsigned u32x2 __attribute__((ext_vector_type(2)));

constexpr int DM = 1024, NB = 4, SEQ = 4096, MTOK = NB * SEQ;
constexpr int HW = 512, NH = 4, HD = 128, CH = 64, NCH = SEQ / CH;
constexpr int INC = 3584, FF = 4096;
constexpr int NUNIT = NB * NH * NCH;
constexpr float ALPHA = 1.189207115002721f;
constexpr float EPS = 1e-5f;
constexpr int PC_Q = 0, PC_K = 512, PC_V = 1024, PC_OG = 1536, PC_B = 2048, PC_C = 2560, PC_U = 3072;

constexpr size_t WS_WIN = 0;
constexpr size_t WS_WOUT = WS_WIN + (size_t)INC * DM * 2;
constexpr size_t WS_WFF1 = WS_WOUT + (size_t)DM * DM * 2;
constexpr size_t WS_WFF2 = WS_WFF1 + (size_t)FF * DM * 2;
constexpr size_t WS_R1 = WS_WFF2 + (size_t)DM * FF * 2;
constexpr size_t WS_R2 = WS_R1 + (size_t)MTOK * FF * 2;
constexpr size_t WS_R3 = WS_R2 + (size_t)MTOK * DM * 2;
constexpr size_t WS_DEC = WS_R3 + (size_t)MTOK * DM * 4;
constexpr size_t WS_END = WS_DEC + (size_t)NUNIT * HD * 4;
constexpr size_t OUT_G = 0, OUT_ST = (size_t)MTOK * HW * 4;

constexpr int LDS_BYTES = 131072;

struct Params {
    const float *x, *w_in, *lbl, *gnw, *convw, *w_out, *ln1g, *ln1b, *w_ff1, *w_ff2, *ln2g, *ln2b;
    float* out; unsigned char* ws; int ph_lo, ph_hi;
};

typedef __bf16 bf16v2 __attribute__((ext_vector_type(2)));
__device__ __forceinline__ unsigned cvt_pk_bf16(float lo, float hi) { f32x2 v = {lo, hi}; bf16v2 r = __builtin_convertvector(v, bf16v2); return __builtin_bit_cast(unsigned, r); }
__device__ __forceinline__ float bf2f(unsigned short b) { return __uint_as_float(((unsigned)b) << 16); }
__device__ __forceinline__ float bflo(unsigned w) { return __uint_as_float(w << 16); }
__device__ __forceinline__ float bfhi(unsigned w) { return __uint_as_float(w & 0xffff0000u); }
__device__ __forceinline__ float fsigmoid(float v) { return __builtin_amdgcn_rcpf(1.0f + __expf(-v)); }
#define LDS_WAIT() asm volatile("s_waitcnt lgkmcnt(0)" ::: "memory")

namespace pg8 {
constexpr int BM = 256, BK = 64, HALF = 128, HTB = HALF * BK * 2, STAGE_BYTES = 8 * HTB, NXCD = 8, WGM = 8;
__host__ __device__ __forceinline__ int lds_byte(int r, int c) { const int st = (r >> 4) * 2 + (c >> 5), rr = r & 15, cc = c & 31, ob = rr * 64 + cc * 2; return st * 1024 + (ob ^ (((ob >> 9) & 1) << 5)); }
__host__ __device__ __forceinline__ void stage_rc(int b, int& R, int& C) { const int st = b / 1024, sb = b % 1024, swz = sb ^ (((sb >> 9) & 1) << 5); R = (st >> 1) * 16 + swz / 64; C = (st & 1) * 32 + (swz % 64) / 2; }
__host__ __device__ __forceinline__ int perm32(int rho) { const int n = rho >> 4, i = rho & 15; return 8 * (i >> 2) + 4 * n + (i & 3); }

struct Unit { int pm, pn; };
struct Gemm { const bf16_t* A; const bf16_t* Bt; int M, N, K; };

struct StaticOrder {
    int nM, nN, nwg, G, c;
    __host__ __device__ void init(int M, int N, int G_, int c_) { nM = M / BM; nN = N / BM; nwg = nM * nN; G = G_; c = c_; }
    __host__ __device__ bool next(int i, Unit& u) const {
        const long L = (long)i * G + c; if (L >= nwg) return false;
        int wgid = (int)L; { const int q = nwg / NXCD, r = nwg % NXCD, xcd = wgid % NXCD, off = wgid / NXCD; wgid = (xcd < r ? xcd * (q + 1) : r * (q + 1) + (xcd - r) * q) + off; }
        const int nig = WGM * nN, gid = wgid / nig, fm = gid * WGM, gsz = (nM - fm) < WGM ? (nM - fm) : WGM;
        u.pm = fm + ((wgid % nig) % gsz); u.pn = (wgid % nig) / gsz; return true;
    }
    __device__ __forceinline__ void a_ready(const Unit&) const {}
    __device__ __forceinline__ void done(const Unit&) const {}
};


struct EpiInProj {
    static constexpr bool PERM = true;
    bf16_t* P; float* G; const float* lbl;
    __device__ __forceinline__ void operator()(const f32x4 (&acc)[2][2][4][2], const Unit& u, int wr, int wc, int fr, int fq) const {
        const int row0 = u.pm * BM + wr * 64 + fr, col0 = u.pn * BM + wc * 32 + 8 * fq;
        const int grp = u.pn >> 1;
        if (grp == 1) {
            float lb[2][8];
#pragma unroll
            for (int bj = 0; bj < 2; ++bj)
#pragma unroll
                for (int j = 0; j < 8; ++j) { const int fc = col0 + bj * HALF + j - PC_K; lb[bj][j] = fsigmoid(lbl[fc] - lbl[HW + fc]); }
#pragma unroll
            for (int ai = 0; ai < 2; ++ai)
#pragma unroll
                for (int m = 0; m < 4; ++m) { const size_t row = (size_t)(row0 + ai * HALF + m * 16);
#pragma unroll
                    for (int bj = 0; bj < 2; ++bj) { const int col = col0 + bj * HALF;
                        float kk[8], gg[8];
#pragma unroll
                        for (int j = 0; j < 8; ++j) { const float v = acc[ai][bj][m][j >> 2][j & 3];
                            const float k1 = (1.0f - lb[bj][j]) * fsigmoid(-v);
                            kk[j] = k1; gg[j] = log1pf(-k1); }
                        float* gp = G + row * HW + (col - PC_K);
                        *(f32x4*)gp = (f32x4){gg[0], gg[1], gg[2], gg[3]}; *(f32x4*)(gp + 4) = (f32x4){gg[4], gg[5], gg[6], gg[7]};
                        u32x4 w; w.x = cvt_pk_bf16(kk[0], kk[1]); w.y = cvt_pk_bf16(kk[2], kk[3]); w.z = cvt_pk_bf16(kk[4], kk[5]); w.w = cvt_pk_bf16(kk[6], kk[7]);
                        *(u32x4*)(P + row * INC + col) = w; } }
        } else {
#pragma unroll
            for (int ai = 0; ai < 2; ++ai)
#pragma unroll
                for (int m = 0; m < 4; ++m) { const size_t row = (size_t)(row0 + ai * HALF + m * 16);
#pragma unroll
                    for (int bj = 0; bj < 2; ++bj) { const int col = col0 + bj * HALF;
                        f32x4 v0 = acc[ai][bj][m][0], v1 = acc[ai][bj][m][1];
                        if (grp == 3) {
#pragma unroll
                            for (int j = 0; j < 4; ++j) { v0[j] = v0[j] * fsigmoid(v0[j]); v1[j] = v1[j] * fsigmoid(v1[j]); } }
                        u32x4 w; w.x = cvt_pk_bf16(v0[0], v0[1]); w.y = cvt_pk_bf16(v0[2], v0[3]); w.z = cvt_pk_bf16(v1[0], v1[1]); w.w = cvt_pk_bf16(v1[2], v1[3]);
                        *(u32x4*)(P + row * INC + col) = w; } }
        }
    }
};
struct EpiResid {
    static constexpr bool PERM = false;
    const float* R; float* O;
    __device__ __forceinline__ void operator()(const f32x4 (&acc)[2][2][4][2], const Unit& u, int wr, int wc, int fr, int fq) const {
        const int row0 = u.pm * BM + wr * 64 + fr, col0 = u.pn * BM + wc * 32 + 4 * fq;
#pragma unroll
        for (int ai = 0; ai < 2; ++ai)
#pragma unroll
            for (int m = 0; m < 4; ++m) { const size_t ro = (size_t)(row0 + ai * HALF + m * 16) * DM + col0;
#pragma unroll
                for (int bj = 0; bj < 2; ++bj)
#pragma unroll
                    for (int n = 0; n < 2; ++n) { const f32x4 r = *(const f32x4*)(R + ro + bj * HALF + n * 16);
                        *(f32x4*)(O + ro + bj * HALF + n * 16) = r * ALPHA + acc[ai][bj][m][n]; } }
    }
};
struct EpiSqRelu {
    static constexpr bool PERM = true;
    bf16_t* O;
    __device__ __forceinline__ void operator()(const f32x4 (&acc)[2][2][4][2], const Unit& u, int wr, int wc, int fr, int fq) const {
        const int row0 = u.pm * BM + wr * 64 + fr, col0 = u.pn * BM + wc * 32 + 8 * fq;
#pragma unroll
        for (int ai = 0; ai < 2; ++ai)
#pragma unroll
            for (int m = 0; m < 4; ++m) { bf16_t* rowp = O + (size_t)(row0 + ai * HALF + m * 16) * FF + col0;
#pragma unroll
                for (int bj = 0; bj < 2; ++bj) { f32x4 v0 = acc[ai][bj][m][0], v1 = acc[ai][bj][m][1];
#pragma unroll
                    for (int j = 0; j < 4; ++j) { const float a = fmaxf(v0[j], 0.f), b = fmaxf(v1[j], 0.f); v0[j] = a * a; v1[j] = b * b; }
                    u32x4 w; w.x = cvt_pk_bf16(v0[0], v0[1]); w.y = cvt_pk_bf16(v0[2], v0[3]); w.z = cvt_pk_bf16(v1[0], v1[1]); w.w = cvt_pk_bf16(v1[2], v1[3]);
                    *(u32x4*)(rowp + bj * HALF) = w; } }
    }
};

template <class Epi, class Sched>
__device__ __forceinline__ void gemm_phase(LAS unsigned char* lds, const Gemm g, const Sched& S, const Epi& E) {
    const int tid = threadIdx.x, wid = __builtin_amdgcn_readfirstlane(tid >> 6), lane = tid & 63, wr = wid >> 2, wc = wid & 3, fr = lane & 15, fq = lane >> 4;
    const int K = g.K, nt = K / BK;
    unsigned voffA[2], voffB[2];
#pragma unroll
    for (int i = 0; i < 2; ++i) { int R, C; stage_rc(tid * 16 + i * 8192, R, C); const int Rb = Epi::PERM ? ((R & ~31) + perm32(R & 31)) : R;
        voffA[i] = (unsigned)(R * K + C) * 2u; voffB[i] = (unsigned)(Rb * K + C) * 2u; }
    const size_t kstep = (size_t)(BK * 2);
    const size_t hstep = (size_t)HALF * K * 2;
    const size_t tstep = 2 * hstep;
    const unsigned ldsw = (unsigned)wid * 1024u;
    const int aoff = lds_byte(wr * 64 + fr, fq * 8), boff = lds_byte(wc * 32 + fr, fq * 8);
#define PG8_SA(b, h) (((b) * 2 + (h)) * HTB)
#define PG8_SB(b, h) ((4 + (b) * 2 + (h)) * HTB)
#define PG8_STAGE(bufoff, gbase, voff) do { _Pragma("unroll") for (int _i = 0; _i < 2; ++_i) \
        __builtin_amdgcn_global_load_lds((const unsigned*)((const char*)(gbase) + (voff)[_i]), (LAS unsigned*)(lds + (bufoff) + ldsw + _i * 8192), 16, 0, 0); } while (0)
#define PG8_LDA(dst, b, h) do { _Pragma("unroll") for (int m = 0; m < 4; ++m) _Pragma("unroll") for (int k = 0; k < 2; ++k) dst[m][k] = *(const LAS bf16x8*)(lds + PG8_SA(b, h) + aoff + m * 2048 + k * 1024); } while (0)
#define PG8_LDB(dst, b, h) do { _Pragma("unroll") for (int n = 0; n < 2; ++n) _Pragma("unroll") for (int k = 0; k < 2; ++k) dst[n][k] = *(const LAS bf16x8*)(lds + PG8_SB(b, h) + boff + n * 2048 + k * 1024); } while (0)
#define PG8_MMA(ai, bj, At, Bt) do { __builtin_amdgcn_s_setprio(1); _Pragma("unroll") for (int m = 0; m < 4; ++m) _Pragma("unroll") for (int n = 0; n < 2; ++n) _Pragma("unroll") for (int k = 0; k < 2; ++k) \
        acc[ai][bj][m][n] = __builtin_amdgcn_mfma_f32_16x16x32_bf16(Bt[n][k], At[m][k], acc[ai][bj][m][n], 0, 0, 0); __builtin_amdgcn_s_setprio(0); } while (0)
#define PG8_WAIT_V(n) asm volatile("s_waitcnt vmcnt(" #n ")" ::: "memory")
#define PG8_WAIT_L(n) asm volatile("s_waitcnt lgkmcnt(" #n ")" ::: "memory")
#define PG8_BAR __builtin_amdgcn_s_barrier()
#define PG8_SCHED __builtin_amdgcn_sched_barrier(0)
    Unit cur, nxt; int ui = 0;
    if (!S.next(0, cur)) return;
    f32x4 acc[2][2][4][2];
#pragma unroll
    for (int a = 0; a < 2; ++a)
#pragma unroll
        for (int b = 0; b < 2; ++b)
#pragma unroll
            for (int m = 0; m < 4; ++m)
#pragma unroll
                for (int n = 0; n < 2; ++n) acc[a][b][m][n] = (f32x4){0.f, 0.f, 0.f, 0.f};
    bf16x8 At[4][2], B0[2][2], B1[2][2];
    const char* cA = (const char*)g.A + (size_t)cur.pm * tstep; const char* cB = (const char*)g.Bt + (size_t)cur.pn * tstep;
    S.a_ready(cur);
    PG8_STAGE(PG8_SB(0, 0), cB, voffB); PG8_STAGE(PG8_SA(0, 0), cA, voffA); PG8_STAGE(PG8_SB(0, 1), cB + hstep, voffB); PG8_STAGE(PG8_SA(0, 1), cA + hstep, voffA);
    if (wr == 1) PG8_BAR;
    PG8_WAIT_V(4); PG8_BAR;
    PG8_STAGE(PG8_SB(1, 0), cB + kstep, voffB); PG8_STAGE(PG8_SA(1, 0), cA + kstep, voffA); PG8_STAGE(PG8_SB(1, 1), cB + hstep + kstep, voffB);
    PG8_WAIT_V(6); PG8_BAR;
    for (;;) {
        const bool has_next = S.next(ui + 1, nxt);
        const char* nA = has_next ? (const char*)g.A + (size_t)nxt.pm * tstep : cA; const char* nB = has_next ? (const char*)g.Bt + (size_t)nxt.pn * tstep : cB;
        for (int t = 0; t < nt; t += 2) {
            const bool last = (t == nt - 2);
            const char* a1 = cA + (size_t)(t + 1) * kstep;
            const char* a2 = last ? nA : cA + (size_t)(t + 2) * kstep; const char* b2 = last ? nB : cB + (size_t)(t + 2) * kstep;
            const char* a3 = a2 + kstep; const char* b3 = b2 + kstep;
            if (last && has_next) S.a_ready(nxt);
            PG8_LDB(B0, 0, 0); PG8_SCHED; PG8_LDA(At, 0, 0); PG8_STAGE(PG8_SA(1, 1), a1 + hstep, voffA);
            PG8_WAIT_L(8); PG8_BAR; PG8_WAIT_L(0); PG8_MMA(0, 0, At, B0); PG8_BAR; PG8_SCHED;
            PG8_LDB(B1, 0, 1); PG8_STAGE(PG8_SB(0, 0), b2, voffB);
            PG8_BAR; PG8_WAIT_L(0); PG8_MMA(0, 1, At, B1); PG8_BAR;
            PG8_LDA(At, 0, 1); PG8_STAGE(PG8_SA(0, 0), a2, voffA);
            PG8_BAR; PG8_WAIT_L(0); PG8_MMA(1, 0, At, B0); PG8_BAR; PG8_SCHED;
            PG8_STAGE(PG8_SB(0, 1), b2 + hstep, voffB);
            PG8_WAIT_V(6); PG8_BAR; PG8_MMA(1, 1, At, B1); PG8_BAR;
            PG8_LDB(B0, 1, 0); PG8_SCHED; PG8_LDA(At, 1, 0); PG8_STAGE(PG8_SA(0, 1), a2 + hstep, voffA);
            PG8_WAIT_L(8); PG8_BAR; PG8_WAIT_L(0); PG8_MMA(0, 0, At, B0); PG8_BAR; PG8_SCHED;
            PG8_LDB(B1, 1, 1); PG8_STAGE(PG8_SB(1, 0), b3, voffB);
            PG8_BAR; PG8_WAIT_L(0); PG8_MMA(0, 1, At, B1); PG8_BAR;
            PG8_LDA(At, 1, 1); PG8_STAGE(PG8_SA(1, 0), a3, voffA);
            PG8_BAR; PG8_WAIT_L(0); PG8_MMA(1, 0, At, B0); PG8_BAR; PG8_SCHED;
            PG8_STAGE(PG8_SB(1, 1), b3 + hstep, voffB);
            PG8_WAIT_V(6); PG8_BAR; PG8_MMA(1, 1, At, B1); PG8_BAR;
        }
        E(acc, cur, wr, wc, fr, fq); S.done(cur);
        if (!has_next) break;
#pragma unroll
        for (int a = 0; a < 2; ++a)
#pragma unroll
            for (int b = 0; b < 2; ++b)
#pragma unroll
                for (int m = 0; m < 4; ++m)
#pragma unroll
                    for (int n = 0; n < 2; ++n) acc[a][b][m][n] = (f32x4){0.f, 0.f, 0.f, 0.f};
        cur = nxt; cA = nA; cB = nB; ++ui;
    }
    PG8_WAIT_V(0);
    if (wr == 0) PG8_BAR;
    PG8_BAR;
#undef PG8_SA
#undef PG8_SB
#undef PG8_STAGE
#undef PG8_LDA
#undef PG8_LDB
#undef PG8_MMA
#undef PG8_WAIT_V
#undef PG8_WAIT_L
#undef PG8_BAR
#undef PG8_SCHED
}
}

__device__ __forceinline__ void transpose_item(const float* W, int K, int N, bf16_t* WT, LAS float* scr, int item, int lane) {
    const int nblk = N / 32, kb = item / nblk, nb = item % nblk, k0 = 64 * kb, n0 = 32 * nb;
#pragma unroll 8
    for (int i = 0; i < 32; ++i) { const int kk = 2 * i + (lane >> 5); scr[kk * 33 + (lane & 31)] = W[(size_t)(k0 + kk) * N + n0 + (lane & 31)]; }
    LDS_WAIT();
    const int c = lane & 7;
#pragma unroll
    for (int j = 0; j < 4; ++j) { const int n = (lane >> 3) + 8 * j; const LAS float* s = scr + (8 * c) * 33 + n;
        u32x4 o; o.x = cvt_pk_bf16(s[0 * 33], s[1 * 33]); o.y = cvt_pk_bf16(s[2 * 33], s[3 * 33]); o.z = cvt_pk_bf16(s[4 * 33], s[5 * 33]); o.w = cvt_pk_bf16(s[6 * 33], s[7 * 33]);
        *(u32x4*)(WT + (size_t)(n0 + n) * K + k0 + 8 * c) = o; }
    LDS_WAIT();
}
__device__ __forceinline__ void phase_convert(const Params& p, LAS unsigned char* lds) {
    const int tid = threadIdx.x, lane = tid & 63, wave = tid >> 6;
    unsigned char* ws = p.ws;
    { bf16_t* XB = (bf16_t*)(ws + WS_R2);
      const size_t nvec = (size_t)MTOK * DM / 8, stride = (size_t)gridDim.x * 512;
      for (size_t i = (size_t)blockIdx.x * 512 + tid; i < nvec; i += stride) {
          const f32x4 a = ((const f32x4*)p.x)[2 * i], b = ((const f32x4*)p.x)[2 * i + 1];
          u32x4 o; o.x = cvt_pk_bf16(a.x, a.y); o.y = cvt_pk_bf16(a.z, a.w); o.z = cvt_pk_bf16(b.x, b.y); o.w = cvt_pk_bf16(b.z, b.w);
          ((u32x4*)XB)[i] = o; } }
    LAS float* scr = (LAS float*)(lds + wave * 16384);
    const int gw = blockIdx.x * 8 + wave, NGW = gridDim.x * 8;
    constexpr int I_IN = (DM / 64) * (INC / 32), I_OUT = (DM / 64) * (DM / 32), I_1 = (DM / 64) * (FF / 32), I_2 = (FF / 64) * (DM / 32);
    for (int it = gw; it < I_IN + I_OUT + I_1 + I_2; it += NGW) {
        int r = it;
        if (r < I_IN) { transpose_item(p.w_in, DM, INC, (bf16_t*)(ws + WS_WIN), scr, r, lane); continue; } r -= I_IN;
        if (r < I_OUT) { transpose_item(p.w_out, DM, DM, (bf16_t*)(ws + WS_WOUT), scr, r, lane); continue; } r -= I_OUT;
        if (r < I_1) { transpose_item(p.w_ff1, DM, FF, (bf16_t*)(ws + WS_WFF1), scr, r, lane); continue; } r -= I_1;
        transpose_item(p.w_ff2, FF, DM, (bf16_t*)(ws + WS_WFF2), scr, r, lane);
    }
}

constexpr int RS128 = 136 * 2;
constexpr int RS64 = 72 * 2;
constexpr int L_QT = 0, L_KT = L_QT + 64 * RS128, L_QI = L_KT + 64 * RS128, L_VT = L_QI + 64 * RS128, L_PS = L_VT + 128 * RS64, L_KS = L_PS + 64 * RS64,
              L_SEG = L_KS + 128 * RS64, L_G32 = L_SEG + 4 * 128 * 4, L_RSS = L_G32 + 128 * 4, L_END = L_RSS + 2 * 64 * 4;
static_assert(L_END <= LDS_BYTES, "LDS");

__device__ __forceinline__ void chunk_cumsum(const float* G, size_t row0, int hc, int col, int seg, LAS unsigned char* lds, float (&b)[16], float& b_last, float& b_ref) {
    const float* gp = G + (row0 + seg * 16) * HW + hc + col;
#pragma unroll
    for (int i = 0; i < 16; ++i) b[i] = gp[(size_t)i * HW];
#pragma unroll
    for (int i = 1; i < 16; ++i) b[i] += b[i - 1];
    LAS float* segt = (LAS float*)(lds + L_SEG); LAS float* g32 = (LAS float*)(lds + L_G32);
    segt[seg * 128 + col] = b[15];
    if (seg == 2) g32[col] = b[0];
    __syncthreads();
    const float s0 = segt[col], s1 = segt[128 + col], s2 = segt[256 + col], s3 = segt[384 + col];
    const float pre = seg == 0 ? 0.f : (seg == 1 ? s0 : (seg == 2 ? s0 + s1 : s0 + s1 + s2));
    b_last = (s0 + s1) + (s2 + s3); b_ref = (s0 + s1) + g32[col];
#pragma unroll
    for (int i = 0; i < 16; ++i) b[i] += pre;
    __syncthreads();
}

__device__ __forceinline__ void phase_local_state(const Params& p, LAS unsigned char* lds) {
    const int tid = threadIdx.x, lane = tid & 63, wave = tid >> 6, col = tid & 127, seg = tid >> 7, fr = lane & 15, fq = lane >> 4;
    const bf16_t* P = (const bf16_t*)(p.ws + WS_R1); const float* G = (const float*)((unsigned char*)p.out + OUT_G);
    bf16_t* ST = (bf16_t*)((unsigned char*)p.out + OUT_ST); float* DEC = (float*)(p.ws + WS_DEC);
    for (int u = blockIdx.x; u < NUNIT; u += gridDim.x) {
        const int bb = u >> 8, h = (u >> 6) & 3, c = u & 63, hc = h * HD; const size_t row0 = (size_t)bb * SEQ + c * CH;
        float b[16], b_last, b_ref;
        chunk_cumsum(G, row0, hc, col, seg, lds, b, b_last, b_ref);
        const bf16_t* pk = P + (row0 + seg * 16) * INC + PC_K + hc + col; const bf16_t* pv = P + (row0 + seg * 16) * INC + PC_V + hc + col;
        float ks[16], vv[16];
#pragma unroll
        for (int i = 0; i < 16; ++i) { ks[i] = bf2f(pk[(size_t)i * INC]) * __expf(b_last - b[i]); vv[i] = bf2f(pv[(size_t)i * INC]); }
        u32x4 w0, w1;
        w0.x = cvt_pk_bf16(ks[0], ks[1]); w0.y = cvt_pk_bf16(ks[2], ks[3]); w0.z = cvt_pk_bf16(ks[4], ks[5]); w0.w = cvt_pk_bf16(ks[6], ks[7]);
        w1.x = cvt_pk_bf16(ks[8], ks[9]); w1.y = cvt_pk_bf16(ks[10], ks[11]); w1.z = cvt_pk_bf16(ks[12], ks[13]); w1.w = cvt_pk_bf16(ks[14], ks[15]);
        *(LAS u32x4*)(lds + L_KS + col * RS64 + seg * 32) = w0; *(LAS u32x4*)(lds + L_KS + col * RS64 + seg * 32 + 16) = w1;
        w0.x = cvt_pk_bf16(vv[0], vv[1]); w0.y = cvt_pk_bf16(vv[2], vv[3]); w0.z = cvt_pk_bf16(vv[4], vv[5]); w0.w = cvt_pk_bf16(vv[6], vv[7]);
        w1.x = cvt_pk_bf16(vv[8], vv[9]); w1.y = cvt_pk_bf16(vv[10], vv[11]); w1.z = cvt_pk_bf16(vv[12], vv[13]); w1.w = cvt_pk_bf16(vv[14], vv[15]);
        *(LAS u32x4*)(lds + L_VT + col * RS64 + seg * 32) = w0; *(LAS u32x4*)(lds + L_VT + col * RS64 + seg * 32 + 16) = w1;
        if (seg == 0) DEC[(size_t)u * HD + col] = __expf(b_last);
        __syncthreads();
        bf16x8 a[2];
#pragma unroll
        for (int s = 0; s < 2; ++s) a[s] = *(const LAS bf16x8*)(lds + L_KS + (wave * 16 + fr) * RS64 + s * 64 + fq * 16);
#pragma unroll
        for (int vt = 0; vt < 8; ++vt) {
            f32x4 acc = (f32x4){0.f, 0.f, 0.f, 0.f};
#pragma unroll
            for (int s = 0; s < 2; ++s) { const bf16x8 bv = *(const LAS bf16x8*)(lds + L_VT + (vt * 16 + fr) * RS64 + s * 64 + fq * 16);
                acc = __builtin_amdgcn_mfma_f32_16x16x32_bf16(a[s], bv, acc, 0, 0, 0); }
            u32x2 o; o.x = cvt_pk_bf16(acc[0], acc[1]); o.y = cvt_pk_bf16(acc[2], acc[3]);
            *(u32x2*)(ST + ((size_t)u * HD + vt * 16 + fr) * HD + wave * 16 + fq * 4) = o;
        }
        __syncthreads();
    }
}

__device__ __forceinline__ void phase_scan(const Params& p) {
    unsigned* ST = (unsigned*)((unsigned char*)p.out + OUT_ST); const float* DEC = (const float*)(p.ws + WS_DEC);
    for (int gid = blockIdx.x * 512 + threadIdx.x; gid < NB * NH * 8192; gid += gridDim.x * 512) {
        const int bh = gid >> 13, e2 = gid & 8191, k2 = e2 & 63;
        unsigned* sp = ST + (size_t)bh * NCH * 8192 + e2; const f32x2* dp = (const f32x2*)DEC + (size_t)bh * NCH * 64 + k2;
        float s0 = 0.f, s1 = 0.f;
        for (int c0 = 0; c0 < NCH; c0 += 16) {
            unsigned loc[16]; f32x2 d[16];
#pragma unroll
            for (int i = 0; i < 16; ++i) { loc[i] = sp[(size_t)(c0 + i) * 8192]; d[i] = dp[(size_t)(c0 + i) * 64]; }
#pragma unroll
            for (int i = 0; i < 16; ++i) { sp[(size_t)(c0 + i) * 8192] = cvt_pk_bf16(s0, s1);
                s0 = d[i].x * s0 + bflo(loc[i]); s1 = d[i].y * s1 + bfhi(loc[i]); }
        }
    }
}

__device__ __forceinline__ void phase_chunk_out(const Params& p, LAS unsigned char* lds) {
    const int tid = threadIdx.x, lane = tid & 63, wave = tid >> 6, col = tid & 127, seg = tid >> 7, fr = lane & 15, fq = lane >> 4;
    const bf16_t* P = (const bf16_t*)(p.ws + WS_R1); const float* G = (const float*)((unsigned char*)p.out + OUT_G);
    const bf16_t* ST = (const bf16_t*)((unsigned char*)p.out + OUT_ST); bf16_t* MIX = (bf16_t*)(p.ws + WS_R2);
    for (int u = blockIdx.x; u < NUNIT; u += gridDim.x) {
        const int bb = u >> 8, h = (u >> 6) & 3, c = u & 63, hc = h * HD; const size_t row0 = (size_t)bb * SEQ + c * CH;
        float b[16], b_last, b_ref;
        chunk_cumsum(G, row0, hc, col, seg, lds, b, b_last, b_ref);
        {
            const bf16_t* pq = P + (row0 + seg * 16) * INC + PC_Q + hc + col; const bf16_t* pk = pq + PC_K; const bf16_t* pv = pq + PC_V;
            float vv[16];
#pragma unroll
            for (int i = 0; i < 16; ++i) { const float q = bf2f(pq[(size_t)i * INC]), kk = bf2f(pk[(size_t)i * INC]); vv[i] = bf2f(pv[(size_t)i * INC]);
                const int t = seg * 16 + i;
                const float qt = q * __expf(b[i] - b_ref), kt = kk * __expf(b_ref - b[i]), qi = q * __expf(b[i]);
                *(LAS bf16_t*)(lds + L_QT + t * RS128 + col * 2) = (bf16_t)(cvt_pk_bf16(qt, 0.f) & 0xffffu);
                *(LAS bf16_t*)(lds + L_KT + t * RS128 + col * 2) = (bf16_t)(cvt_pk_bf16(kt, 0.f) & 0xffffu);
                *(LAS bf16_t*)(lds + L_QI + t * RS128 + col * 2) = (bf16_t)(cvt_pk_bf16(qi, 0.f) & 0xffffu); }
            u32x4 w0, w1;
            w0.x = cvt_pk_bf16(vv[0], vv[1]); w0.y = cvt_pk_bf16(vv[2], vv[3]); w0.z = cvt_pk_bf16(vv[4], vv[5]); w0.w = cvt_pk_bf16(vv[6], vv[7]);
            w1.x = cvt_pk_bf16(vv[8], vv[9]); w1.y = cvt_pk_bf16(vv[10], vv[11]); w1.z = cvt_pk_bf16(vv[12], vv[13]); w1.w = cvt_pk_bf16(vv[14], vv[15]);
            *(LAS u32x4*)(lds + L_VT + col * RS64 + seg * 32) = w0; *(LAS u32x4*)(lds + L_VT + col * RS64 + seg * 32 + 16) = w1;
        }
        __syncthreads();
        const int tt = wave >> 1, vh = wave & 1;
#pragma unroll
        for (int si = 0; si < 2; ++si) { const int st = vh * 2 + si;
            f32x4 acc = (f32x4){0.f, 0.f, 0.f, 0.f};
            if (st <= tt) {
#pragma unroll
                for (int s = 0; s < 4; ++s) { const bf16x8 a = *(const LAS bf16x8*)(lds + L_QT + (tt * 16 + fr) * RS128 + s * 64 + fq * 16);
                    const bf16x8 bv = *(const LAS bf16x8*)(lds + L_KT + (st * 16 + fr) * RS128 + s * 64 + fq * 16);
                    acc = __builtin_amdgcn_mfma_f32_16x16x32_bf16(a, bv, acc, 0, 0, 0); }
            }
#pragma unroll
            for (int j = 0; j < 4; ++j) { const int t = tt * 16 + fq * 4 + j, s = st * 16 + fr; const float v = (s <= t) ? acc[j] : 0.f;
                *(LAS bf16_t*)(lds + L_PS + t * RS64 + s * 2) = (bf16_t)(cvt_pk_bf16(v, 0.f) & 0xffffu); }
        }
        __syncthreads();
        f32x4 oacc[4];
        {
            bf16x8 pa[2], qa[4];
#pragma unroll
            for (int s = 0; s < 2; ++s) pa[s] = *(const LAS bf16x8*)(lds + L_PS + (tt * 16 + fr) * RS64 + s * 64 + fq * 16);
#pragma unroll
            for (int s = 0; s < 4; ++s) qa[s] = *(const LAS bf16x8*)(lds + L_QI + (tt * 16 + fr) * RS128 + s * 64 + fq * 16);
#pragma unroll
            for (int i = 0; i < 4; ++i) { const int vt = vh * 4 + i;
                f32x4 acc = (f32x4){0.f, 0.f, 0.f, 0.f};
                const bf16_t* sp = ST + ((size_t)u * HD + vt * 16 + fr) * HD + fq * 8;
                bf16x8 sb[4];
#pragma unroll
                for (int s = 0; s < 4; ++s) sb[s] = *(const bf16x8*)(sp + s * 32);
#pragma unroll
                for (int s = 0; s < 2; ++s) { const bf16x8 vb = *(const LAS bf16x8*)(lds + L_VT + (vt * 16 + fr) * RS64 + s * 64 + fq * 16);
                    acc = __builtin_amdgcn_mfma_f32_16x16x32_bf16(vb, pa[s], acc, 0, 0, 0); }
#pragma unroll
                for (int s = 0; s < 4; ++s) acc = __builtin_amdgcn_mfma_f32_16x16x32_bf16(sb[s], qa[s], acc, 0, 0, 0);
                oacc[i] = acc; }
        }
        float ss = 0.f;
#pragma unroll
        for (int i = 0; i < 4; ++i)
#pragma unroll
            for (int j = 0; j < 4; ++j) ss += oacc[i][j] * oacc[i][j];
        ss += __shfl_xor(ss, 16); ss += __shfl_xor(ss, 32);
        LAS float* rss = (LAS float*)(lds + L_RSS);
        if (fq == 0) rss[vh * 64 + tt * 16 + fr] = ss;
        __syncthreads();
        {
            const int t = tt * 16 + fr;
            const float rinv = rsqrtf((rss[t] + rss[64 + t]) * (1.0f / HD) + EPS);
            const size_t row = row0 + t;
#pragma unroll
            for (int i = 0; i < 4; ++i) { const int v = (vh * 4 + i) * 16 + fq * 4;
                const f32x4 gw = *(const f32x4*)(p.gnw + hc + v);
                const u32x2 og = *(const u32x2*)(P + row * INC + PC_OG + hc + v);
                const float o0 = oacc[i][0] * rinv * gw.x * bflo(og.x), o1 = oacc[i][1] * rinv * gw.y * bfhi(og.x);
                const float o2 = oacc[i][2] * rinv * gw.z * bflo(og.y), o3 = oacc[i][3] * rinv * gw.w * bfhi(og.y);
                u32x2 o; o.x = cvt_pk_bf16(o0, o1); o.y = cvt_pk_bf16(o2, o3);
                *(u32x2*)(MIX + row * DM + hc + v) = o; }
        }
        {
            const int cp = tid & 63, sg = tid >> 6, ch = hc + 2 * cp;
            const f32x2 w0 = *(const f32x2*)(p.convw + ch), w1 = *(const f32x2*)(p.convw + HW + ch), w2 = *(const f32x2*)(p.convw + 2 * HW + ch);
            const int tpos0 = c * CH + sg * 8;
            const size_t r0 = row0 + sg * 8;
            float cu0x = 0.f, cu0y = 0.f, cu1x = 0.f, cu1y = 0.f;
            if (tpos0 >= 2) { const unsigned cc = *(const unsigned*)(P + (r0 - 2) * INC + PC_C + ch), uu = *(const unsigned*)(P + (r0 - 2) * INC + PC_U + ch); cu0x = bflo(cc) * bflo(uu); cu0y = bfhi(cc) * bfhi(uu); }
            if (tpos0 >= 1) { const unsigned cc = *(const unsigned*)(P + (r0 - 1) * INC + PC_C + ch), uu = *(const unsigned*)(P + (r0 - 1) * INC + PC_U + ch); cu1x = bflo(cc) * bflo(uu); cu1y = bfhi(cc) * bfhi(uu); }
#pragma unroll
            for (int i = 0; i < 8; ++i) { const size_t r = r0 + i;
                const unsigned cc = *(const unsigned*)(P + r * INC + PC_C + ch), uu = *(const unsigned*)(P + r * INC + PC_U + ch), bg = *(const unsigned*)(P + r * INC + PC_B + ch);
                const float cx = bflo(cc) * bflo(uu), cy = bfhi(cc) * bfhi(uu);
                const float yx = bflo(bg) * (w0.x * cu0x + w1.x * cu1x + w2.x * cx), yy = bfhi(bg) * (w0.y * cu0y + w1.y * cu1y + w2.y * cy);
                *(unsigned*)(MIX + r * DM + HW + ch) = cvt_pk_bf16(yx, yy);
                cu0x = cu1x; cu0y = cu1y; cu1x = cx; cu1y = cy; }
        }
        __syncthreads();
    }
}

__device__ __forceinline__ float wave_sum(float v) {
#pragma unroll
    for (int o = 1; o < 64; o <<= 1) v += __shfl_xor(v, o);
    return v;
}
template <bool WITH_BF16>
__device__ __forceinline__ void phase_layernorm(float* Z, const float* gam, const float* bet, bf16_t* OB) {
    const int lane = threadIdx.x & 63, wave = threadIdx.x >> 6;
    f32x4 gv[4], bv[4];
#pragma unroll
    for (int j = 0; j < 4; ++j) { gv[j] = ((const f32x4*)gam)[lane + 64 * j]; bv[j] = ((const f32x4*)bet)[lane + 64 * j]; }
    for (int row = blockIdx.x * 8 + wave; row < MTOK; row += gridDim.x * 8) {
        f32x4* zr = (f32x4*)(Z + (size_t)row * DM) + lane;
        f32x4 v[4]; float s = 0.f;
#pragma unroll
        for (int j = 0; j < 4; ++j) { v[j] = zr[64 * j]; s += (v[j].x + v[j].y) + (v[j].z + v[j].w); }
        const float mean = wave_sum(s) * (1.f / DM); float s2 = 0.f;
#pragma unroll
        for (int j = 0; j < 4; ++j) { v[j] = v[j] - mean; s2 += (v[j].x * v[j].x + v[j].y * v[j].y) + (v[j].z * v[j].z + v[j].w * v[j].w); }
        const float rstd = rsqrtf(wave_sum(s2) * (1.f / DM) + EPS);
#pragma unroll
        for (int j = 0; j < 4; ++j) { v[j] = v[j] * rstd * gv[j] + bv[j];
            zr[64 * j] = v[j]; }
        if (WITH_BF16) { u32x2* o8 = (u32x2*)(OB + (size_t)row * DM) + lane;
#pragma unroll
            for (int j = 0; j < 4; ++j) { u32x2 o; o.x = cvt_pk_bf16(v[j].x, v[j].y); o.y = cvt_pk_bf16(v[j].z, v[j].w); o8[64 * j] = o; } }
    }
}

constexpr int NPHASE = 10;
__global__ void __launch_bounds__(512, 2) hybrid_layer_fwd(Params p) {
    extern __shared__ __attribute__((aligned(16))) unsigned char smem[];
    LAS unsigned char* lds = (LAS unsigned char*)smem;
    cg::grid_group grid = cg::this_grid();
    unsigned char* ws = p.ws;
    pg8::StaticOrder so;
#define PHASE(n) if (p.ph_lo <= (n) && (n) < p.ph_hi)
#define SEAM(n) if (p.ph_lo < (n) && (n) < p.ph_hi) grid.sync();
    PHASE(0) phase_convert(p, lds);
    SEAM(1)
    PHASE(1) { pg8::Gemm g{(const bf16_t*)(ws + WS_R2), (const bf16_t*)(ws + WS_WIN), MTOK, INC, DM}; so.init(MTOK, INC, gridDim.x, blockIdx.x);
        pg8::EpiInProj e{(bf16_t*)(ws + WS_R1), (float*)((unsigned char*)p.out + OUT_G), p.lbl}; pg8::gemm_phase(lds, g, so, e); }
    SEAM(2)
    PHASE(2) phase_local_state(p, lds);
    SEAM(3)
    PHASE(3) phase_scan(p);
    SEAM(4)
    PHASE(4) phase_chunk_out(p, lds);
    SEAM(5)
    PHASE(5) { pg8::Gemm g{(const bf16_t*)(ws + WS_R2), (const bf16_t*)(ws + WS_WOUT), MTOK, DM, DM}; so.init(MTOK, DM, gridDim.x, blockIdx.x);
        pg8::EpiResid e{p.x, (float*)(ws + WS_R3)}; pg8::gemm_phase(lds, g, so, e); }
    SEAM(6)
    PHASE(6) phase_layernorm<true>((float*)(ws + WS_R3), p.ln1g, p.ln1b, (bf16_t*)(ws + WS_R2));
    SEAM(7)
    PHASE(7) { pg8::Gemm g{(const bf16_t*)(ws + WS_R2), (const bf16_t*)(ws + WS_WFF1), MTOK, FF, DM}; so.init(MTOK, FF, gridDim.x, blockIdx.x);
        pg8::EpiSqRelu e{(bf16_t*)(ws + WS_R1)}; pg8::gemm_phase(lds, g, so, e); }
    SEAM(8)
    PHASE(8) { pg8::Gemm g{(const bf16_t*)(ws + WS_R1), (const bf16_t*)(ws + WS_WFF2), MTOK, DM, FF}; so.init(MTOK, DM, gridDim.x, blockIdx.x);
        pg8::EpiResid e{(const float*)(ws + WS_R3), p.out}; pg8::gemm_phase(lds, g, so, e); }
    SEAM(9)
    PHASE(9) phase_layernorm<false>(p.out, p.ln2g, p.ln2b, nullptr);
}


#ifndef N_LAUNCH_SPLIT
#define N_LAUNCH_SPLIT 1
#endif

extern "C" void kernel_launch(void* const* d_in, const int* in_sizes, int n_in, void* d_out, int out_size, void* d_ws, size_t ws_size, hipStream_t stream) {
    static int grid = 0;
    if (grid == 0) {
        if (n_in != 12 || in_sizes[0] != MTOK * DM || out_size != MTOK * DM || ws_size < WS_END) {
            fprintf(stderr, "kernel_launch: unexpected shapes (n_in %d, in0 %d, out %d, ws %zu, need %zu)\n", n_in, n_in > 0 ? in_sizes[0] : -1, out_size, ws_size, (size_t)WS_END); grid = -1; return; }
        int dev = 0, cus = 0, per_cu = 0;
        (void)hipGetDevice(&dev); (void)hipDeviceGetAttribute(&cus, hipDeviceAttributeMultiprocessorCount, dev);
        if (hipFuncSetAttribute((const void*)hybrid_layer_fwd, hipFuncAttributeMaxDynamicSharedMemorySize, LDS_BYTES) != hipSuccess) { fprintf(stderr, "kernel_launch: hipFuncSetAttribute failed\n"); grid = -1; return; }
        if (hipOccupancyMaxActiveBlocksPerMultiprocessor(&per_cu, (const void*)hybrid_layer_fwd, 512, LDS_BYTES) != hipSuccess || per_cu < 1) { fprintf(stderr, "kernel_launch: occupancy query says %d\n", per_cu); per_cu = 1; }
        (void)hipGetLastError();
        grid = cus * 1;
        if (grid <= 0) grid = 256;
    }
    if (grid < 0) return;
    Params p{};
    p.x = (const float*)d_in[0]; p.w_in = (const float*)d_in[1]; p.lbl = (const float*)d_in[2]; p.gnw = (const float*)d_in[3]; p.convw = (const float*)d_in[4];
    p.w_out = (const float*)d_in[5]; p.ln1g = (const float*)d_in[6]; p.ln1b = (const float*)d_in[7]; p.w_ff1 = (const float*)d_in[8]; p.w_ff2 = (const float*)d_in[9];
    p.ln2g = (const float*)d_in[10]; p.ln2b = (const float*)d_in[11]; p.out = (float*)d_out; p.ws = (unsigned char*)d_ws;
#if N_LAUNCH_SPLIT
    p.ph_lo = 0; p.ph_hi = NPHASE;
    void* args[] = {&p};
    hipError_t e = hipLaunchCooperativeKernel((const void*)hybrid_layer_fwd, dim3(grid), dim3(512), args, LDS_BYTES, stream);
    if (e != hipSuccess) fprintf(stderr, "cooperative launch failed: %s (grid %d)\n", hipGetErrorString(e), grid);
#else
    for (int ph = 0; ph < NPHASE; ++ph) { p.ph_lo = ph; p.ph_hi = ph + 1;
        hipLaunchKernelGGL(hybrid_layer_fwd, dim3(grid), dim3(512), LDS_BYTES, stream, p); }
#endif
}
```

```cpp
#include <hip/hip_runtime.h>
#include <hip/hip_cooperative_groups.h>
#include <cstdio>
namespace cg = cooperative_groups;

#define LAS __attribute__((address_space(3)))
typedef unsigned short bf16_t;
typedef short bf16x8 __attribute__((ext_vector_type(8)));
typedef float f32x4 __attribute__((ext_vector_type(4)));
typedef float f32x2 __attribute__((ext_vector_type(2)));
typedef unsigned u32x4 __attribute__((ext_vector_type(4)));
typedef unsigned u32x2 __attribute__((ext_vector_type(2)));

constexpr int DM = 1024, NB = 4, SEQ = 4096, MTOK = NB * SEQ;
constexpr int HW = 512, NH = 4, HD = 128, CH = 64, NCH = SEQ / CH;
constexpr int INC = 3584, FF = 4096;
constexpr int NUNIT = NB * NH * NCH;
constexpr float ALPHA = 1.189207115002721f;
constexpr float EPS = 1e-5f;
constexpr int PC_Q = 0, PC_K = 512, PC_V = 1024, PC_OG = 1536, PC_B = 2048, PC_C = 2560, PC_U = 3072;

constexpr size_t WS_WIN = 0;
constexpr size_t WS_WOUT = WS_WIN + (size_t)INC * DM * 2;
constexpr size_t WS_WFF1 = WS_WOUT + (size_t)DM * DM * 2;
constexpr size_t WS_WFF2 = WS_WFF1 + (size_t)FF * DM * 2;
constexpr size_t WS_R1 = WS_WFF2 + (size_t)DM * FF * 2;
constexpr size_t WS_R2 = WS_R1 + (size_t)MTOK * FF * 2;
constexpr size_t WS_R3 = WS_R2 + (size_t)MTOK * DM * 2;
constexpr size_t WS_DEC = WS_R3 + (size_t)MTOK * DM * 4;
constexpr size_t WS_BAR = WS_DEC + (size_t)NUNIT * HD * 4;
constexpr size_t WS_END = WS_BAR + 16384;
constexpr size_t OUT_G = 0, OUT_ST = (size_t)MTOK * HW * 4;

constexpr int LDS_STAGE = 131072, LDS_BYTES = LDS_STAGE + 64;

struct Params {
    const float *x, *w_in, *lbl, *gnw, *convw, *w_out, *ln1g, *ln1b, *w_ff1, *w_ff2, *ln2g, *ln2b;
    float* out; unsigned char* ws; int ph_lo, ph_hi;
};

typedef __bf16 bf16v2 __attribute__((ext_vector_type(2)));
__device__ __forceinline__ unsigned cvt_pk_bf16(float lo, float hi) { f32x2 v = {lo, hi}; bf16v2 r = __builtin_convertvector(v, bf16v2); return __builtin_bit_cast(unsigned, r); }
__device__ __forceinline__ float bf2f(unsigned short b) { return __uint_as_float(((unsigned)b) << 16); }
__device__ __forceinline__ float bflo(unsigned w) { return __uint_as_float(w << 16); }
__device__ __forceinline__ float bfhi(unsigned w) { return __uint_as_float(w & 0xffff0000u); }
__device__ __forceinline__ float fsigmoid(float v) { return __builtin_amdgcn_rcpf(1.0f + __expf(-v)); }
#define LDS_WAIT() asm volatile("s_waitcnt lgkmcnt(0)" ::: "memory")

namespace pg8 {
constexpr int BM = 256, BK = 64, HALF = 128, HTB = HALF * BK * 2, STAGE_BYTES = 8 * HTB, NXCD = 8, WGM = 8;
__host__ __device__ __forceinline__ int lds_byte(int r, int c) { const int st = (r >> 4) * 2 + (c >> 5), rr = r & 15, cc = c & 31, ob = rr * 64 + cc * 2; return st * 1024 + (ob ^ (((ob >> 9) & 1) << 5)); }
__host__ __device__ __forceinline__ void stage_rc(int b, int& R, int& C) { const int st = b / 1024, sb = b % 1024, swz = sb ^ (((sb >> 9) & 1) << 5); R = (st >> 1) * 16 + swz / 64; C = (st & 1) * 32 + (swz % 64) / 2; }
__host__ __device__ __forceinline__ int perm32(int rho) { const int n = rho >> 4, i = rho & 15; return 8 * (i >> 2) + 4 * n + (i & 3); }

struct Unit { int pm, pn; };
struct Gemm { const bf16_t* A; const bf16_t* Bt; int M, N, K; };

struct StaticOrder {
    int nM, nN, nwg, G, c;
    __host__ __device__ void init(int M, int N, int G_, int c_) { nM = M / BM; nN = N / BM; nwg = nM * nN; G = G_; c = c_; }
    __host__ __device__ bool next(int i, Unit& u) const {
        const long L = (long)i * G + c; if (L >= nwg) return false;
        int wgid = (int)L; { const int q = nwg / NXCD, r = nwg % NXCD, xcd = wgid % NXCD, off = wgid / NXCD; wgid = (xcd < r ? xcd * (q + 1) : r * (q + 1) + (xcd - r) * q) + off; }
        const int nig = WGM * nN, gid = wgid / nig, fm = gid * WGM, gsz = (nM - fm) < WGM ? (nM - fm) : WGM;
        u.pm = fm + ((wgid % nig) % gsz); u.pn = (wgid % nig) / gsz; return true;
    }
    __device__ __forceinline__ void a_ready(const Unit&) const {}
    __device__ __forceinline__ void done(const Unit&) const {}
};


struct EpiInProj {
    static constexpr bool PERM = true;
    bf16_t* P; float* G; const float* lbl;
    __device__ __forceinline__ void operator()(const f32x4 (&acc)[2][2][4][2], const Unit& u, int wr, int wc, int fr, int fq) const {
        const int row0 = u.pm * BM + wr * 64 + fr, col0 = u.pn * BM + wc * 32 + 8 * fq;
        const int grp = u.pn >> 1;
        if (grp == 1) {
            float lb[2][8];
#pragma unroll
            for (int bj = 0; bj < 2; ++bj)
#pragma unroll
                for (int j = 0; j < 8; ++j) { const int fc = col0 + bj * HALF + j - PC_K; lb[bj][j] = fsigmoid(lbl[fc] - lbl[HW + fc]); }
#pragma unroll
            for (int ai = 0; ai < 2; ++ai)
#pragma unroll
                for (int m = 0; m < 4; ++m) { const size_t row = (size_t)(row0 + ai * HALF + m * 16);
#pragma unroll
                    for (int bj = 0; bj < 2; ++bj) { const int col = col0 + bj * HALF;
                        float kk[8], gg[8];
#pragma unroll
                        for (int j = 0; j < 8; ++j) { const float v = acc[ai][bj][m][j >> 2][j & 3];
                            const float k1 = (1.0f - lb[bj][j]) * fsigmoid(-v);
                            kk[j] = k1; gg[j] = log1pf(-k1); }
                        float* gp = G + row * HW + (col - PC_K);
                        *(f32x4*)gp = (f32x4){gg[0], gg[1], gg[2], gg[3]}; *(f32x4*)(gp + 4) = (f32x4){gg[4], gg[5], gg[6], gg[7]};
                        u32x4 w; w.x = cvt_pk_bf16(kk[0], kk[1]); w.y = cvt_pk_bf16(kk[2], kk[3]); w.z = cvt_pk_bf16(kk[4], kk[5]); w.w = cvt_pk_bf16(kk[6], kk[7]);
                        *(u32x4*)(P + row * INC + col) = w; } }
        } else {
#pragma unroll
            for (int ai = 0; ai < 2; ++ai)
#pragma unroll
                for (int m = 0; m < 4; ++m) { const size_t row = (size_t)(row0 + ai * HALF + m * 16);
#pragma unroll
                    for (int bj = 0; bj < 2; ++bj) { const int col = col0 + bj * HALF;
                        f32x4 v0 = acc[ai][bj][m][0], v1 = acc[ai][bj][m][1];
                        if (grp == 3) {
#pragma unroll
                            for (int j = 0; j < 4; ++j) { v0[j] = v0[j] * fsigmoid(v0[j]); v1[j] = v1[j] * fsigmoid(v1[j]); } }
                        u32x4 w; w.x = cvt_pk_bf16(v0[0], v0[1]); w.y = cvt_pk_bf16(v0[2], v0[3]); w.z = cvt_pk_bf16(v1[0], v1[1]); w.w = cvt_pk_bf16(v1[2], v1[3]);
                        *(u32x4*)(P + row * INC + col) = w; } }
        }
    }
};
struct EpiResid {
    static constexpr bool PERM = false;
    const float* R; float* O;
    __device__ __forceinline__ void operator()(const f32x4 (&acc)[2][2][4][2], const Unit& u, int wr, int wc, int fr, int fq) const {
        const int row0 = u.pm * BM + wr * 64 + fr, col0 = u.pn * BM + wc * 32 + 4 * fq;
#pragma unroll
        for (int ai = 0; ai < 2; ++ai)
#pragma unroll
            for (int m = 0; m < 4; ++m) { const size_t ro = (size_t)(row0 + ai * HALF + m * 16) * DM + col0;
#pragma unroll
                for (int bj = 0; bj < 2; ++bj)
#pragma unroll
                    for (int n = 0; n < 2; ++n) { const f32x4 r = *(const f32x4*)(R + ro + bj * HALF + n * 16);
                        *(f32x4*)(O + ro + bj * HALF + n * 16) = r * ALPHA + acc[ai][bj][m][n]; } }
    }
};
struct EpiSqRelu {
    static constexpr bool PERM = true;
    bf16_t* O;
    __device__ __forceinline__ void operator()(const f32x4 (&acc)[2][2][4][2], const Unit& u, int wr, int wc, int fr, int fq) const {
        const int row0 = u.pm * BM + wr * 64 + fr, col0 = u.pn * BM + wc * 32 + 8 * fq;
#pragma unroll
        for (int ai = 0; ai < 2; ++ai)
#pragma unroll
            for (int m = 0; m < 4; ++m) { bf16_t* rowp = O + (size_t)(row0 + ai * HALF + m * 16) * FF + col0;
#pragma unroll
                for (int bj = 0; bj < 2; ++bj) { f32x4 v0 = acc[ai][bj][m][0], v1 = acc[ai][bj][m][1];
#pragma unroll
                    for (int j = 0; j < 4; ++j) { const float a = fmaxf(v0[j], 0.f), b = fmaxf(v1[j], 0.f); v0[j] = a * a; v1[j] = b * b; }
                    u32x4 w; w.x = cvt_pk_bf16(v0[0], v0[1]); w.y = cvt_pk_bf16(v0[2], v0[3]); w.z = cvt_pk_bf16(v1[0], v1[1]); w.w = cvt_pk_bf16(v1[2], v1[3]);
                    *(u32x4*)(rowp + bj * HALF) = w; } }
    }
};

template <class Epi, class Sched>
__device__ __forceinline__ void gemm_phase(LAS unsigned char* lds, const Gemm g, const Sched& S, const Epi& E) {
    const int tid = threadIdx.x, wid = __builtin_amdgcn_readfirstlane(tid >> 6), lane = tid & 63, wr = wid >> 2, wc = wid & 3, fr = lane & 15, fq = lane >> 4;
    const int K = g.K, nt = K / BK;
    unsigned voffA[2], voffB[2];
#pragma unroll
    for (int i = 0; i < 2; ++i) { int R, C; stage_rc(tid * 16 + i * 8192, R, C); const int Rb = Epi::PERM ? ((R & ~31) + perm32(R & 31)) : R;
        voffA[i] = (unsigned)(R * K + C) * 2u; voffB[i] = (unsigned)(Rb * K + C) * 2u; }
    const size_t kstep = (size_t)(BK * 2);
    const size_t hstep = (size_t)HALF * K * 2;
    const size_t tstep = 2 * hstep;
    const unsigned ldsw = (unsigned)wid * 1024u;
    const int aoff = lds_byte(wr * 64 + fr, fq * 8), boff = lds_byte(wc * 32 + fr, fq * 8);
#define PG8_SA(b, h) (((b) * 2 + (h)) * HTB)
#define PG8_SB(b, h) ((4 + (b) * 2 + (h)) * HTB)
#define PG8_STAGE(bufoff, gbase, voff) do { _Pragma("unroll") for (int _i = 0; _i < 2; ++_i) \
        __builtin_amdgcn_global_load_lds((const unsigned*)((const char*)(gbase) + (voff)[_i]), (LAS unsigned*)(lds + (bufoff) + ldsw + _i * 8192), 16, 0, 0); } while (0)
#define PG8_LDA(dst, b, h) do { _Pragma("unroll") for (int m = 0; m < 4; ++m) _Pragma("unroll") for (int k = 0; k < 2; ++k) dst[m][k] = *(const LAS bf16x8*)(lds + PG8_SA(b, h) + aoff + m * 2048 + k * 1024); } while (0)
#define PG8_LDB(dst, b, h) do { _Pragma("unroll") for (int n = 0; n < 2; ++n) _Pragma("unroll") for (int k = 0; k < 2; ++k) dst[n][k] = *(const LAS bf16x8*)(lds + PG8_SB(b, h) + boff + n * 2048 + k * 1024); } while (0)
#define PG8_MMA(ai, bj, At, Bt) do { __builtin_amdgcn_s_setprio(1); _Pragma("unroll") for (int m = 0; m < 4; ++m) _Pragma("unroll") for (int n = 0; n < 2; ++n) _Pragma("unroll") for (int k = 0; k < 2; ++k) \
        acc[ai][bj][m][n] = __builtin_amdgcn_mfma_f32_16x16x32_bf16(Bt[n][k], At[m][k], acc[ai][bj][m][n], 0, 0, 0); __builtin_amdgcn_s_setprio(0); } while (0)
#define PG8_WAIT_V(n) asm volatile("s_waitcnt vmcnt(" #n ")" ::: "memory")
#define PG8_WAIT_L(n) asm volatile("s_waitcnt lgkmcnt(" #n ")" ::: "memory")
#define PG8_BAR __builtin_amdgcn_s_barrier()
#define PG8_SCHED __builtin_amdgcn_sched_barrier(0)
    Unit cur, nxt; int ui = 0;
    if (!S.next(0, cur)) return;
    f32x4 acc[2][2][4][2];
#pragma unroll
    for (int a = 0; a < 2; ++a)
#pragma unroll
        for (int b = 0; b < 2; ++b)
#pragma unroll
            for (int m = 0; m < 4; ++m)
#pragma unroll
                for (int n = 0; n < 2; ++n) acc[a][b][m][n] = (f32x4){0.f, 0.f, 0.f, 0.f};
    bf16x8 At[4][2], B0[2][2], B1[2][2];
    const char* cA = (const char*)g.A + (size_t)cur.pm * tstep; const char* cB = (const char*)g.Bt + (size_t)cur.pn * tstep;
    S.a_ready(cur);
    PG8_STAGE(PG8_SB(0, 0), cB, voffB); PG8_STAGE(PG8_SA(0, 0), cA, voffA); PG8_STAGE(PG8_SB(0, 1), cB + hstep, voffB); PG8_STAGE(PG8_SA(0, 1), cA + hstep, voffA);
    if (wr == 1) PG8_BAR;
    PG8_WAIT_V(4); PG8_BAR;
    PG8_STAGE(PG8_SB(1, 0), cB + kstep, voffB); PG8_STAGE(PG8_SA(1, 0), cA + kstep, voffA); PG8_STAGE(PG8_SB(1, 1), cB + hstep + kstep, voffB);
    PG8_WAIT_V(6); PG8_BAR;
    for (;;) {
        const bool has_next = S.next(ui + 1, nxt);
        const char* nA = has_next ? (const char*)g.A + (size_t)nxt.pm * tstep : cA; const char* nB = has_next ? (const char*)g.Bt + (size_t)nxt.pn * tstep : cB;
        for (int t = 0; t < nt; t += 2) {
            const bool last = (t == nt - 2);
            const char* a1 = cA + (size_t)(t + 1) * kstep;
            const char* a2 = last ? nA : cA + (size_t)(t + 2) * kstep; const char* b2 = last ? nB : cB + (size_t)(t + 2) * kstep;
            const char* a3 = a2 + kstep; const char* b3 = b2 + kstep;
            if (last && has_next) S.a_ready(nxt);
            PG8_LDB(B0, 0, 0); PG8_SCHED; PG8_LDA(At, 0, 0); PG8_STAGE(PG8_SA(1, 1), a1 + hstep, voffA);
            PG8_WAIT_L(8); PG8_BAR; PG8_WAIT_L(0); PG8_MMA(0, 0, At, B0); PG8_BAR; PG8_SCHED;
            PG8_LDB(B1, 0, 1); PG8_STAGE(PG8_SB(0, 0), b2, voffB);
            PG8_BAR; PG8_WAIT_L(0); PG8_MMA(0, 1, At, B1); PG8_BAR;
            PG8_LDA(At, 0, 1); PG8_STAGE(PG8_SA(0, 0), a2, voffA);
            PG8_BAR; PG8_WAIT_L(0); PG8_MMA(1, 0, At, B0); PG8_BAR; PG8_SCHED;
            PG8_STAGE(PG8_SB(0, 1), b2 + hstep, voffB);
            PG8_WAIT_V(6); PG8_BAR; PG8_MMA(1, 1, At, B1); PG8_BAR;
            PG8_LDB(B0, 1, 0); PG8_SCHED; PG8_LDA(At, 1, 0); PG8_STAGE(PG8_SA(0, 1), a2 + hstep, voffA);
            PG8_WAIT_L(8); PG8_BAR; PG8_WAIT_L(0); PG8_MMA(0, 0, At, B0); PG8_BAR; PG8_SCHED;
            PG8_LDB(B1, 1, 1); PG8_STAGE(PG8_SB(1, 0), b3, voffB);
            PG8_BAR; PG8_WAIT_L(0); PG8_MMA(0, 1, At, B1); PG8_BAR;
            PG8_LDA(At, 1, 1); PG8_STAGE(PG8_SA(1, 0), a3, voffA);
            PG8_BAR; PG8_WAIT_L(0); PG8_MMA(1, 0, At, B0); PG8_BAR; PG8_SCHED;
            PG8_STAGE(PG8_SB(1, 1), b3 + hstep, voffB);
            PG8_WAIT_V(6); PG8_BAR; PG8_MMA(1, 1, At, B1); PG8_BAR;
        }
        E(acc, cur, wr, wc, fr, fq); S.done(cur);
        if (!has_next) break;
#pragma unroll
        for (int a = 0; a < 2; ++a)
#pragma unroll
            for (int b = 0; b < 2; ++b)
#pragma unroll
                for (int m = 0; m < 4; ++m)
#pragma unroll
                    for (int n = 0; n < 2; ++n) acc[a][b][m][n] = (f32x4){0.f, 0.f, 0.f, 0.f};
        cur = nxt; cA = nA; cB = nB; ++ui;
    }
    PG8_WAIT_V(0);
    if (wr == 0) PG8_BAR;
    PG8_BAR;
#undef PG8_SA
#undef PG8_SB
#undef PG8_STAGE
#undef PG8_LDA
#undef PG8_LDB
#undef PG8_MMA
#undef PG8_WAIT_V
#undef PG8_WAIT_L
#undef PG8_BAR
#undef PG8_SCHED
}
}

__device__ __forceinline__ void transpose_item(const float* W, int K, int N, bf16_t* WT, LAS float* scr, int item, int lane) {
    const int nblk = N / 32, kb = item / nblk, nb = item % nblk, k0 = 64 * kb, n0 = 32 * nb;
#pragma unroll 8
    for (int i = 0; i < 32; ++i) { const int kk = 2 * i + (lane >> 5); scr[kk * 33 + (lane & 31)] = W[(size_t)(k0 + kk) * N + n0 + (lane & 31)]; }
    LDS_WAIT();
    const int c = lane & 7;
#pragma unroll
    for (int j = 0; j < 4; ++j) { const int n = (lane >> 3) + 8 * j; const LAS float* s = scr + (8 * c) * 33 + n;
        u32x4 o; o.x = cvt_pk_bf16(s[0 * 33], s[1 * 33]); o.y = cvt_pk_bf16(s[2 * 33], s[3 * 33]); o.z = cvt_pk_bf16(s[4 * 33], s[5 * 33]); o.w = cvt_pk_bf16(s[6 * 33], s[7 * 33]);
        *(u32x4*)(WT + (size_t)(n0 + n) * K + k0 + 8 * c) = o; }
    LDS_WAIT();
}
__device__ __forceinline__ void phase_convert(const Params& p, LAS unsigned char* lds) {
    const int tid = threadIdx.x, lane = tid & 63, wave = tid >> 6;
    unsigned char* ws = p.ws;
    { bf16_t* XB = (bf16_t*)(ws + WS_R2);
      const size_t nvec = (size_t)MTOK * DM / 8, stride = (size_t)gridDim.x * 512;
      for (size_t i = (size_t)blockIdx.x * 512 + tid; i < nvec; i += stride) {
          const f32x4 a = ((const f32x4*)p.x)[2 * i], b = ((const f32x4*)p.x)[2 * i + 1];
          u32x4 o; o.x = cvt_pk_bf16(a.x, a.y); o.y = cvt_pk_bf16(a.z, a.w); o.z = cvt_pk_bf16(b.x, b.y); o.w = cvt_pk_bf16(b.z, b.w);
          ((u32x4*)XB)[i] = o; } }
    LAS float* scr = (LAS float*)(lds + wave * 16384);
    const int gw = blockIdx.x * 8 + wave, NGW = gridDim.x * 8;
    constexpr int I_IN = (DM / 64) * (INC / 32), I_OUT = (DM / 64) * (DM / 32), I_1 = (DM / 64) * (FF / 32), I_2 = (FF / 64) * (DM / 32);
    for (int it = gw; it < I_IN + I_OUT + I_1 + I_2; it += NGW) {
        int r = it;
        if (r < I_IN) { transpose_item(p.w_in, DM, INC, (bf16_t*)(ws + WS_WIN), scr, r, lane); continue; } r -= I_IN;
        if (r < I_OUT) { transpose_item(p.w_out, DM, DM, (bf16_t*)(ws + WS_WOUT), scr, r, lane); continue; } r -= I_OUT;
        if (r < I_1) { transpose_item(p.w_ff1, DM, FF, (bf16_t*)(ws + WS_WFF1), scr, r, lane); continue; } r -= I_1;
        transpose_item(p.w_ff2, FF, DM, (bf16_t*)(ws + WS_WFF2), scr, r, lane);
    }
}

constexpr int RS128 = 136 * 2;
constexpr int RS64 = 72 * 2;
constexpr int L_QT = 0, L_KT = L_QT + 64 * RS128, L_QI = L_KT + 64 * RS128, L_VT = L_QI + 64 * RS128, L_PS = L_VT + 128 * RS64, L_KS = L_PS + 64 * RS64,
              L_SEG = L_KS + 128 * RS64, L_G32 = L_SEG + 4 * 128 * 4, L_RSS = L_G32 + 128 * 4, L_END = L_RSS + 2 * 64 * 4;
static_assert(L_END <= LDS_STAGE, "LDS");

__device__ __forceinline__ void chunk_cumsum(const float* G, size_t row0, int hc, int col, int seg, LAS unsigned char* lds, float (&b)[16], float& b_last, float& b_ref) {
    const float* gp = G + (row0 + seg * 16) * HW + hc + col;
#pragma unroll
    for (int i = 0; i < 16; ++i) b[i] = gp[(size_t)i * HW];
#pragma unroll
    for (int i = 1; i < 16; ++i) b[i] += b[i - 1];
    LAS float* segt = (LAS float*)(lds + L_SEG); LAS float* g32 = (LAS float*)(lds + L_G32);
    segt[seg * 128 + col] = b[15];
    if (seg == 2) g32[col] = b[0];
    __syncthreads();
    const float s0 = segt[col], s1 = segt[128 + col], s2 = segt[256 + col], s3 = segt[384 + col];
    const float pre = seg == 0 ? 0.f : (seg == 1 ? s0 : (seg == 2 ? s0 + s1 : s0 + s1 + s2));
    b_last = (s0 + s1) + (s2 + s3); b_ref = (s0 + s1) + g32[col];
#pragma unroll
    for (int i = 0; i < 16; ++i) b[i] += pre;
    __syncthreads();
}

__device__ __forceinline__ void phase_local_state(const Params& p, LAS unsigned char* lds) {
    const int tid = threadIdx.x, lane = tid & 63, wave = tid >> 6, col = tid & 127, seg = tid >> 7, fr = lane & 15, fq = lane >> 4;
    const bf16_t* P = (const bf16_t*)(p.ws + WS_R1); const float* G = (const float*)((unsigned char*)p.out + OUT_G);
    bf16_t* ST = (bf16_t*)((unsigned char*)p.out + OUT_ST); float* DEC = (float*)(p.ws + WS_DEC);
    for (int u = blockIdx.x; u < NUNIT; u += gridDim.x) {
        const int bb = u >> 8, h = (u >> 6) & 3, c = u & 63, hc = h * HD; const size_t row0 = (size_t)bb * SEQ + c * CH;
        float b[16], b_last, b_ref;
        chunk_cumsum(G, row0, hc, col, seg, lds, b, b_last, b_ref);
        const bf16_t* pk = P + (row0 + seg * 16) * INC + PC_K + hc + col; const bf16_t* pv = P + (row0 + seg * 16) * INC + PC_V + hc + col;
        float ks[16], vv[16];
#pragma unroll
        for (int i = 0; i < 16; ++i) { ks[i] = bf2f(pk[(size_t)i * INC]) * __expf(b_last - b[i]); vv[i] = bf2f(pv[(size_t)i * INC]); }
        u32x4 w0, w1;
        w0.x = cvt_pk_bf16(ks[0], ks[1]); w0.y = cvt_pk_bf16(ks[2], ks[3]); w0.z = cvt_pk_bf16(ks[4], ks[5]); w0.w = cvt_pk_bf16(ks[6], ks[7]);
        w1.x = cvt_pk_bf16(ks[8], ks[9]); w1.y = cvt_pk_bf16(ks[10], ks[11]); w1.z = cvt_pk_bf16(ks[12], ks[13]); w1.w = cvt_pk_bf16(ks[14], ks[15]);
        *(LAS u32x4*)(lds + L_KS + col * RS64 + seg * 32) = w0; *(LAS u32x4*)(lds + L_KS + col * RS64 + seg * 32 + 16) = w1;
        w0.x = cvt_pk_bf16(vv[0], vv[1]); w0.y = cvt_pk_bf16(vv[2], vv[3]); w0.z = cvt_pk_bf16(vv[4], vv[5]); w0.w = cvt_pk_bf16(vv[6], vv[7]);
        w1.x = cvt_pk_bf16(vv[8], vv[9]); w1.y = cvt_pk_bf16(vv[10], vv[11]); w1.z = cvt_pk_bf16(vv[12], vv[13]); w1.w = cvt_pk_bf16(vv[14], vv[15]);
        *(LAS u32x4*)(lds + L_VT + col * RS64 + seg * 32) = w0; *(LAS u32x4*)(lds + L_VT + col * RS64 + seg * 32 + 16) = w1;
        if (seg == 0) DEC[(size_t)u * HD + col] = __expf(b_last);
        __syncthreads();
        bf16x8 a[2];
#pragma unroll
        for (int s = 0; s < 2; ++s) a[s] = *(const LAS bf16x8*)(lds + L_KS + (wave * 16 + fr) * RS64 + s * 64 + fq * 16);
#pragma unroll
        for (int vt = 0; vt < 8; ++vt) {
            f32x4 acc = (f32x4){0.f, 0.f, 0.f, 0.f};
#pragma unroll
            for (int s = 0; s < 2; ++s) { const bf16x8 bv = *(const LAS bf16x8*)(lds + L_VT + (vt * 16 + fr) * RS64 + s * 64 + fq * 16);
                acc = __builtin_amdgcn_mfma_f32_16x16x32_bf16(a[s], bv, acc, 0, 0, 0); }
            u32x2 o; o.x = cvt_pk_bf16(acc[0], acc[1]); o.y = cvt_pk_bf16(acc[2], acc[3]);
            *(u32x2*)(ST + ((size_t)u * HD + vt * 16 + fr) * HD + wave * 16 + fq * 4) = o;
        }
        __syncthreads();
    }
}

__device__ __forceinline__ void phase_scan(const Params& p) {
    unsigned* ST = (unsigned*)((unsigned char*)p.out + OUT_ST); const float* DEC = (const float*)(p.ws + WS_DEC);
    for (int gid = blockIdx.x * 512 + threadIdx.x; gid < NB * NH * 8192; gid += gridDim.x * 512) {
        const int bh = gid >> 13, e2 = gid & 8191, k2 = e2 & 63;
        unsigned* sp = ST + (size_t)bh * NCH * 8192 + e2; const f32x2* dp = (const f32x2*)DEC + (size_t)bh * NCH * 64 + k2;
        float s0 = 0.f, s1 = 0.f;
        for (int c0 = 0; c0 < NCH; c0 += 16) {
            unsigned loc[16]; f32x2 d[16];
#pragma unroll
            for (int i = 0; i < 16; ++i) { loc[i] = sp[(size_t)(c0 + i) * 8192]; d[i] = dp[(size_t)(c0 + i) * 64]; }
#pragma unroll
            for (int i = 0; i < 16; ++i) { sp[(size_t)(c0 + i) * 8192] = cvt_pk_bf16(s0, s1);
                s0 = d[i].x * s0 + bflo(loc[i]); s1 = d[i].y * s1 + bfhi(loc[i]); }
        }
    }
}

__device__ __forceinline__ void phase_chunk_out(const Params& p, LAS unsigned char* lds) {
    const int tid = threadIdx.x, lane = tid & 63, wave = tid >> 6, col = tid & 127, seg = tid >> 7, fr = lane & 15, fq = lane >> 4;
    const bf16_t* P = (const bf16_t*)(p.ws + WS_R1); const float* G = (const float*)((unsigned char*)p.out + OUT_G);
    const bf16_t* ST = (const bf16_t*)((unsigned char*)p.out + OUT_ST); bf16_t* MIX = (bf16_t*)(p.ws + WS_R2);
    for (int u = blockIdx.x; u < NUNIT; u += gridDim.x) {
        const int bb = u >> 8, h = (u >> 6) & 3, c = u & 63, hc = h * HD; const size_t row0 = (size_t)bb * SEQ + c * CH;
        float b[16], b_last, b_ref;
        chunk_cumsum(G, row0, hc, col, seg, lds, b, b_last, b_ref);
        {
            const bf16_t* pq = P + (row0 + seg * 16) * INC + PC_Q + hc + col; const bf16_t* pk = pq + PC_K; const bf16_t* pv = pq + PC_V;
            float vv[16];
#pragma unroll
            for (int i = 0; i < 16; ++i) { const float q = bf2f(pq[(size_t)i * INC]), kk = bf2f(pk[(size_t)i * INC]); vv[i] = bf2f(pv[(size_t)i * INC]);
                const int t = seg * 16 + i;
                const float qt = q * __expf(b[i] - b_ref), kt = kk * __expf(b_ref - b[i]), qi = q * __expf(b[i]);
                *(LAS bf16_t*)(lds + L_QT + t * RS128 + col * 2) = (bf16_t)(cvt_pk_bf16(qt, 0.f) & 0xffffu);
                *(LAS bf16_t*)(lds + L_KT + t * RS128 + col * 2) = (bf16_t)(cvt_pk_bf16(kt, 0.f) & 0xffffu);
                *(LAS bf16_t*)(lds + L_QI + t * RS128 + col * 2) = (bf16_t)(cvt_pk_bf16(qi, 0.f) & 0xffffu); }
            u32x4 w0, w1;
            w0.x = cvt_pk_bf16(vv[0], vv[1]); w0.y = cvt_pk_bf16(vv[2], vv[3]); w0.z = cvt_pk_bf16(vv[4], vv[5]); w0.w = cvt_pk_bf16(vv[6], vv[7]);
            w1.x = cvt_pk_bf16(vv[8], vv[9]); w1.y = cvt_pk_bf16(vv[10], vv[11]); w1.z = cvt_pk_bf16(vv[12], vv[13]); w1.w = cvt_pk_bf16(vv[14], vv[15]);
            *(LAS u32x4*)(lds + L_VT + col * RS64 + seg * 32) = w0; *(LAS u32x4*)(lds + L_VT + col * RS64 + seg * 32 + 16) = w1;
        }
        __syncthreads();
        const int tt = wave >> 1, vh = wave & 1;
#pragma unroll
        for (int si = 0; si < 2; ++si) { const int st = vh * 2 + si;
            f32x4 acc = (f32x4){0.f, 0.f, 0.f, 0.f};
            if (st <= tt) {
#pragma unroll
                for (int s = 0; s < 4; ++s) { const bf16x8 a = *(const LAS bf16x8*)(lds + L_QT + (tt * 16 + fr) * RS128 + s * 64 + fq * 16);
                    const bf16x8 bv = *(const LAS bf16x8*)(lds + L_KT + (st * 16 + fr) * RS128 + s * 64 + fq * 16);
                    acc = __builtin_amdgcn_mfma_f32_16x16x32_bf16(a, bv, acc, 0, 0, 0); }
            }
#pragma unroll
            for (int j = 0; j < 4; ++j) { const int t = tt * 16 + fq * 4 + j, s = st * 16 + fr; const float v = (s <= t) ? acc[j] : 0.f;
                *(LAS bf16_t*)(lds + L_PS + t * RS64 + s * 2) = (bf16_t)(cvt_pk_bf16(v, 0.f) & 0xffffu); }
        }
        __syncthreads();
        f32x4 oacc[4];
        {
            bf16x8 pa[2], qa[4];
#pragma unroll
            for (int s = 0; s < 2; ++s) pa[s] = *(const LAS bf16x8*)(lds + L_PS + (tt * 16 + fr) * RS64 + s * 64 + fq * 16);
#pragma unroll
            for (int s = 0; s < 4; ++s) qa[s] = *(const LAS bf16x8*)(lds + L_QI + (tt * 16 + fr) * RS128 + s * 64 + fq * 16);
#pragma unroll
            for (int i = 0; i < 4; ++i) { const int vt = vh * 4 + i;
                f32x4 acc = (f32x4){0.f, 0.f, 0.f, 0.f};
                const bf16_t* sp = ST + ((size_t)u * HD + vt * 16 + fr) * HD + fq * 8;
                bf16x8 sb[4];
#pragma unroll
                for (int s = 0; s < 4; ++s) sb[s] = *(const bf16x8*)(sp + s * 32);
#pragma unroll
                for (int s = 0; s < 2; ++s) { const bf16x8 vb = *(const LAS bf16x8*)(lds + L_VT + (vt * 16 + fr) * RS64 + s * 64 + fq * 16);
                    acc = __builtin_amdgcn_mfma_f32_16x16x32_bf16(vb, pa[s], acc, 0, 0, 0); }
#pragma unroll
                for (int s = 0; s < 4; ++s) acc = __builtin_amdgcn_mfma_f32_16x16x32_bf16(sb[s], qa[s], acc, 0, 0, 0);
                oacc[i] = acc; }
        }
        float ss = 0.f;
#pragma unroll
        for (int i = 0; i < 4; ++i)
#pragma unroll
            for (int j = 0; j < 4; ++j) ss += oacc[i][j] * oacc[i][j];
        ss += __shfl_xor(ss, 16); ss += __shfl_xor(ss, 32);
        LAS float* rss = (LAS float*)(lds + L_RSS);
        if (fq == 0) rss[vh * 64 + tt * 16 + fr] = ss;
        __syncthreads();
        {
            const int t = tt * 16 + fr;
            const float rinv = rsqrtf((rss[t] + rss[64 + t]) * (1.0f / HD) + EPS);
            const size_t row = row0 + t;
#pragma unroll
            for (int i = 0; i < 4; ++i) { const int v = (vh * 4 + i) * 16 + fq * 4;
                const f32x4 gw = *(const f32x4*)(p.gnw + hc + v);
                const u32x2 og = *(const u32x2*)(P + row * INC + PC_OG + hc + v);
                const float o0 = oacc[i][0] * rinv * gw.x * bflo(og.x), o1 = oacc[i][1] * rinv * gw.y * bfhi(og.x);
                const float o2 = oacc[i][2] * rinv * gw.z * bflo(og.y), o3 = oacc[i][3] * rinv * gw.w * bfhi(og.y);
                u32x2 o; o.x = cvt_pk_bf16(o0, o1); o.y = cvt_pk_bf16(o2, o3);
                *(u32x2*)(MIX + row * DM + hc + v) = o; }
        }
        {
            const int cp = tid & 63, sg = tid >> 6, ch = hc + 2 * cp;
            const f32x2 w0 = *(const f32x2*)(p.convw + ch), w1 = *(const f32x2*)(p.convw + HW + ch), w2 = *(const f32x2*)(p.convw + 2 * HW + ch);
            const int tpos0 = c * CH + sg * 8;
            const size_t r0 = row0 + sg * 8;
            float cu0x = 0.f, cu0y = 0.f, cu1x = 0.f, cu1y = 0.f;
            if (tpos0 >= 2) { const unsigned cc = *(const unsigned*)(P + (r0 - 2) * INC + PC_C + ch), uu = *(const unsigned*)(P + (r0 - 2) * INC + PC_U + ch); cu0x = bflo(cc) * bflo(uu); cu0y = bfhi(cc) * bfhi(uu); }
            if (tpos0 >= 1) { const unsigned cc = *(const unsigned*)(P + (r0 - 1) * INC + PC_C + ch), uu = *(const unsigned*)(P + (r0 - 1) * INC + PC_U + ch); cu1x = bflo(cc) * bflo(uu); cu1y = bfhi(cc) * bfhi(uu); }
#pragma unroll
            for (int i = 0; i < 8; ++i) { const size_t r = r0 + i;
                const unsigned cc = *(const unsigned*)(P + r * INC + PC_C + ch), uu = *(const unsigned*)(P + r * INC + PC_U + ch), bg = *(const unsigned*)(P + r * INC + PC_B + ch);
                const float cx = bflo(cc) * bflo(uu), cy = bfhi(cc) * bfhi(uu);
                const float yx = bflo(bg) * (w0.x * cu0x + w1.x * cu1x + w2.x * cx), yy = bfhi(bg) * (w0.y * cu0y + w1.y * cu1y + w2.y * cy);
                *(unsigned*)(MIX + r * DM + HW + ch) = cvt_pk_bf16(yx, yy);
                cu0x = cu1x; cu0y = cu1y; cu1x = cx; cu1y = cy; }
        }
        __syncthreads();
    }
}

__device__ __forceinline__ float wave_sum(float v) {
#pragma unroll
    for (int o = 1; o < 64; o <<= 1) v += __shfl_xor(v, o);
    return v;
}
template <bool WITH_BF16>
__device__ __forceinline__ void phase_layernorm(float* Z, const float* gam, const float* bet, bf16_t* OB) {
    const int lane = threadIdx.x & 63, wave = threadIdx.x >> 6;
    f32x4 gv[4], bv[4];
#pragma unroll
    for (int j = 0; j < 4; ++j) { gv[j] = ((const f32x4*)gam)[lane + 64 * j]; bv[j] = ((const f32x4*)bet)[lane + 64 * j]; }
    for (int row = blockIdx.x * 8 + wave; row < MTOK; row += gridDim.x * 8) {
        f32x4* zr = (f32x4*)(Z + (size_t)row * DM) + lane;
        f32x4 v[4]; float s = 0.f;
#pragma unroll
        for (int j = 0; j < 4; ++j) { v[j] = zr[64 * j]; s += (v[j].x + v[j].y) + (v[j].z + v[j].w); }
        const float mean = wave_sum(s) * (1.f / DM); float s2 = 0.f;
#pragma unroll
        for (int j = 0; j < 4; ++j) { v[j] = v[j] - mean; s2 += (v[j].x * v[j].x + v[j].y * v[j].y) + (v[j].z * v[j].z + v[j].w * v[j].w); }
        const float rstd = rsqrtf(wave_sum(s2) * (1.f / DM) + EPS);
#pragma unroll
        for (int j = 0; j < 4; ++j) { v[j] = v[j] * rstd * gv[j] + bv[j];
            zr[64 * j] = v[j]; }
        if (WITH_BF16) { u32x2* o8 = (u32x2*)(OB + (size_t)row * DM) + lane;
#pragma unroll
            for (int j = 0; j < 4; ++j) { u32x2 o; o.x = cvt_pk_bf16(v[j].x, v[j].y); o.y = cvt_pk_bf16(v[j].z, v[j].w); o8[64 * j] = o; } }
    }
}


#define XB_TMO      128
#define XB_XCNT(j)  (256  + 64 * (j))
#define XB_XSUB(j)  (1280 + 64 * (j))
#define XB_XGEN(j)  (2304 + 64 * (j))
#define XB_TOP      3328
#define XB_TOPGEN   3392
#define XCD_BAR_WORDS 3456
#define XB_SPIN_CAP (1u << 18)
__device__ __forceinline__ unsigned xb_ld(unsigned* p)              { return __hip_atomic_load(p, __ATOMIC_RELAXED, __HIP_MEMORY_SCOPE_AGENT); }
__device__ __forceinline__ unsigned xb_add(unsigned* p, unsigned v) { return __hip_atomic_fetch_add(p, v, __ATOMIC_RELAXED, __HIP_MEMORY_SCOPE_AGENT); }
__device__ __forceinline__ unsigned xb_xcc_id() { return (unsigned)__builtin_amdgcn_s_getreg((3 << 11) | 20) & 0xFu; }
#define XB_SPIN(cond, bar) do { unsigned _sp = 0; while (cond) { __builtin_amdgcn_s_sleep(1); \
    if ((++_sp & 255u) == 0u) { if (xb_ld(&(bar)[XB_TMO])) break; if (_sp > XB_SPIN_CAP) { atomicAdd(&(bar)[XB_TMO], 1u); break; } } } } while (0)
struct XcdBarrier { unsigned* bar; unsigned x; volatile LAS unsigned* st; };
__device__ __forceinline__ XcdBarrier xcd_barrier_post(unsigned* bar, volatile LAS unsigned* st) {
    XcdBarrier b; b.bar = bar; b.x = xb_xcc_id(); b.st = st;
    if (threadIdx.x == 0) (void)xb_add(&bar[XB_XCNT(b.x)], 1u);
    return b;
}
__device__ __forceinline__ void xcd_barrier_complete(unsigned* bar, unsigned x, unsigned& nloc, unsigned& nx) {
    const unsigned G = gridDim.x * gridDim.y * gridDim.z;
    unsigned sum, cnt, mine, sp = 0u;
    for (;;) {
        sum = 0u; cnt = 0u; mine = 0u;
#pragma unroll
        for (unsigned j = 0; j < 16; ++j) { const unsigned c = xb_ld(&bar[XB_XCNT(j)]); sum += c; cnt += (c > 0u) ? 1u : 0u; mine = (j == x) ? c : mine; }
        if (sum == G) break;
        __builtin_amdgcn_s_sleep(1);
        if ((++sp & 255u) == 0u) { if (xb_ld(&bar[XB_TMO])) break; if (sp > XB_SPIN_CAP) { atomicAdd(&bar[XB_TMO], 1u); break; } }
    }
    nloc = mine > 0u ? mine : 1u; nx = cnt > 0u ? cnt : 1u;
}
__device__ __forceinline__ void xcd_barrier(const XcdBarrier& b) {
    asm volatile("s_waitcnt vmcnt(0)" ::: "memory");
    __syncthreads();
    if (threadIdx.x == 0) {
        unsigned* bar = b.bar;
        __builtin_amdgcn_s_waitcnt(0);
        unsigned nloc = b.st[0], nx = b.st[1];
        if (nloc == 0u) { xcd_barrier_complete(bar, b.x, nloc, nx); b.st[0] = nloc; b.st[1] = nx; }
        const unsigned old = xb_add(&bar[XB_XSUB(b.x)], 1u);
        const unsigned gen = old / nloc;
        if (old + 1u == (gen + 1u) * nloc) {
            __builtin_amdgcn_fence(__ATOMIC_RELEASE, "agent");
            asm volatile("s_waitcnt vmcnt(0)" ::: "memory");
            const unsigned og = xb_add(&bar[XB_TOP], 1u);
            const unsigned tg = og / nx;
            if (og + 1u == (tg + 1u) * nx) xb_add(&bar[XB_TOPGEN], 1u);
            else XB_SPIN(xb_ld(&bar[XB_TOPGEN]) == tg, bar);
            __builtin_amdgcn_fence(__ATOMIC_ACQUIRE, "agent");
            xb_add(&bar[XB_XGEN(b.x)], 1u);
            asm volatile("s_waitcnt vmcnt(0)" ::: "memory");
        } else {
            XB_SPIN(xb_ld(&bar[XB_XGEN(b.x)]) == gen, bar);
            __builtin_amdgcn_fence(__ATOMIC_ACQUIRE, "agent");
            asm volatile("s_waitcnt vmcnt(0)" ::: "memory");
        }
    }
    __syncthreads();
}

constexpr int NPHASE = 10;
__global__ void __launch_bounds__(512, 2) hybrid_layer_fwd(Params p) {
    extern __shared__ __attribute__((aligned(16))) unsigned char smem[];
    LAS unsigned char* lds = (LAS unsigned char*)smem;
    cg::grid_group grid = cg::this_grid();
    unsigned char* ws = p.ws;
    pg8::StaticOrder so;
#ifndef REP_MASK
#define REP_MASK 0
#endif
#ifndef EXTRA_SYNCS
#define EXTRA_SYNCS 0
#endif
#define PHASE(n) for (int _r = 0; _r < 1 + ((REP_MASK >> (n)) & 1); ++_r) if (p.ph_lo <= (n) && (n) < p.ph_hi)
#define SEAM(n) if (p.ph_lo < (n) && (n) < p.ph_hi) xcd_barrier(bar);
    if (p.ph_lo < 0) grid.sync();
    volatile LAS unsigned* bst = (volatile LAS unsigned*)(lds + LDS_STAGE);
    if (threadIdx.x == 0) { bst[0] = 0u; bst[1] = 0u; }
    __syncthreads();
    XcdBarrier bar = xcd_barrier_post((unsigned*)(ws + WS_BAR), bst);
    for (int i = 0; i < EXTRA_SYNCS; ++i) xcd_barrier(bar);
    PHASE(0) phase_convert(p, lds);
    SEAM(1)
    PHASE(1) { pg8::Gemm g{(const bf16_t*)(ws + WS_R2), (const bf16_t*)(ws + WS_WIN), MTOK, INC, DM}; so.init(MTOK, INC, gridDim.x, blockIdx.x);
        pg8::EpiInProj e{(bf16_t*)(ws + WS_R1), (float*)((unsigned char*)p.out + OUT_G), p.lbl}; pg8::gemm_phase(lds, g, so, e); }
    SEAM(2)
    PHASE(2) phase_local_state(p, lds);
    SEAM(3)
    PHASE(3) phase_scan(p);
    SEAM(4)
    PHASE(4) phase_chunk_out(p, lds);
    SEAM(5)
    PHASE(5) { pg8::Gemm g{(const bf16_t*)(ws + WS_R2), (const bf16_t*)(ws + WS_WOUT), MTOK, DM, DM}; so.init(MTOK, DM, gridDim.x, blockIdx.x);
        pg8::EpiResid e{p.x, (float*)(ws + WS_R3)}; pg8::gemm_phase(lds, g, so, e); }
    SEAM(6)
    PHASE(6) phase_layernorm<true>((float*)(ws + WS_R3), p.ln1g, p.ln1b, (bf16_t*)(ws + WS_R2));
    SEAM(7)
    PHASE(7) { pg8::Gemm g{(const bf16_t*)(ws + WS_R2), (const bf16_t*)(ws + WS_WFF1), MTOK, FF, DM}; so.init(MTOK, FF, gridDim.x, blockIdx.x);
        pg8::EpiSqRelu e{(bf16_t*)(ws + WS_R1)}; pg8::gemm_phase(lds, g, so, e); }
    SEAM(8)
    PHASE(8) { pg8::Gemm g{(const bf16_t*)(ws + WS_R1), (const bf16_t*)(ws + WS_WFF2), MTOK, DM, FF}; so.init(MTOK, DM, gridDim.x, blockIdx.x);
        pg8::EpiResid e{(const float*)(ws + WS_R3), p.out}; pg8::gemm_phase(lds, g, so, e); }
    SEAM(9)
    PHASE(9) phase_layernorm<false>(p.out, p.ln2g, p.ln2b, nullptr);
}


#ifndef N_LAUNCH_SPLIT
#define N_LAUNCH_SPLIT 1
#endif

extern "C" void kernel_launch(void* const* d_in, const int* in_sizes, int n_in, void* d_out, int out_size, void* d_ws, size_t ws_size, hipStream_t stream) {
    static int grid = 0;
    if (grid == 0) {
        if (n_in != 12 || in_sizes[0] != MTOK * DM || out_size != MTOK * DM || ws_size < WS_END) {
            fprintf(stderr, "kernel_launch: unexpected shapes (n_in %d, in0 %d, out %d, ws %zu, need %zu)\n", n_in, n_in > 0 ? in_sizes[0] : -1, out_size, ws_size, (size_t)WS_END); grid = -1; return; }
        int dev = 0, cus = 0, per_cu = 0;
        (void)hipGetDevice(&dev); (void)hipDeviceGetAttribute(&cus, hipDeviceAttributeMultiprocessorCount, dev);
        if (hipFuncSetAttribute((const void*)hybrid_layer_fwd, hipFuncAttributeMaxDynamicSharedMemorySize, LDS_BYTES) != hipSuccess) { fprintf(stderr, "kernel_launch: hipFuncSetAttribute failed\n"); grid = -1; return; }
        if (hipOccupancyMaxActiveBlocksPerMultiprocessor(&per_cu, (const void*)hybrid_layer_fwd, 512, LDS_BYTES) != hipSuccess || per_cu < 1) { fprintf(stderr, "kernel_launch: occupancy query says %d\n", per_cu); per_cu = 1; }
        (void)hipGetLastError();
        grid = cus * 1;
        if (grid <= 0) grid = 256;
    }
    if (grid < 0) return;
    Params p{};
    p.x = (const float*)d_in[0]; p.w_in = (const float*)d_in[1]; p.lbl = (const float*)d_in[2]; p.gnw = (const float*)d_in[3]; p.convw = (const float*)d_in[4];
    p.w_out = (const float*)d_in[5]; p.ln1g = (const float*)d_in[6]; p.ln1b = (const float*)d_in[7]; p.w_ff1 = (const float*)d_in[8]; p.w_ff2 = (const float*)d_in[9];
    p.ln2g = (const float*)d_in[10]; p.ln2b = (const float*)d_in[11]; p.out = (float*)d_out; p.ws = (unsigned char*)d_ws;
#if N_LAUNCH_SPLIT
    (void)hipMemsetAsync((unsigned char*)d_ws + WS_BAR, 0, XCD_BAR_WORDS * 4, stream);
    p.ph_lo = 0; p.ph_hi = NPHASE;
    void* args[] = {&p};
    hipError_t e = hipLaunchCooperativeKernel((const void*)hybrid_layer_fwd, dim3(grid), dim3(512), args, LDS_BYTES, stream);
    if (e != hipSuccess) fprintf(stderr, "cooperative launch failed: %s (grid %d)\n", hipGetErrorString(e), grid);
#else
    for (int ph = 0; ph < NPHASE; ++ph) { p.ph_lo = ph; p.ph_hi = ph + 1;
        hipLaunchKernelGGL(hybrid_layer_fwd, dim3(grid), dim3(512), LDS_BYTES, stream, p); }
#endif
}
```
